# Optimizing an MI355X kernel written in HIP

```python
import math
import jax, jax.numpy as jnp
from jax import lax
import numpy as np

D_MODEL = 1024
BATCH = 16
SEQ = 2048
DEPTH = 4
DEC_BATCH = 128
DEC_SEQ = 4
PAST_LEN = 8192
PAGE_SIZE = 128

N_A_LAYERS = DEPTH // 2
N_B_LAYERS = DEPTH - N_A_LAYERS
SSM_EXPAND = 2
SSM_WIDTH = SSM_EXPAND * D_MODEL
GROUP_CH = 16
N_GROUPS = SSM_WIDTH // GROUP_CH
STATE_DIM = 64
SCAN_CHUNK = 128
N_HEADS = D_MODEL // 128
QK_NOPE = 128
QK_ROPE = 64
V_HEAD = 128
KV_LORA = D_MODEL // 4
Q_LORA = 3 * D_MODEL // 8
ATTN_WIDTH = N_HEADS * V_HEAD
Q_BLOCK = 128
ROPE_THETA = 10000.0
RMS_EPS = 1e-6
SOFTMAX_SCALE = 1.0 / math.sqrt(QK_NOPE + QK_ROPE)
NEG_INF = -1e30

kernel_name = 'yoco_s5_mla_hybrid_step'


def rms_norm(x, g):
    x32 = x.astype(jnp.float32)
    y = x32 * lax.rsqrt(jnp.mean(x32 * x32, axis=-1, keepdims=True) + RMS_EPS) * g.astype(jnp.float32)
    return y.astype(x.dtype)


def rope(x, pos):
    half = x.shape[-1] // 2
    inv = ROPE_THETA ** (-jnp.arange(half, dtype=jnp.float32) / half)
    ang = pos.astype(jnp.float32)[:, None] * inv[None, :]
    shape = (1, pos.shape[0]) + (1,) * (x.ndim - 3) + (half,)
    cos = jnp.cos(ang).reshape(shape)
    sin = jnp.sin(ang).reshape(shape)
    x1 = x[..., :half].astype(jnp.float32)
    x2 = x[..., half:].astype(jnp.float32)
    return jnp.concatenate([x1 * cos - x2 * sin, x1 * sin + x2 * cos], axis=-1).astype(x.dtype)


def s5_scan(u, h0_re, h0_im, a_re, a_im, log_dt, b_re, b_im, c_re, c_im, d_skip):
    bsz, L, _ = u.shape
    u32 = u.astype(jnp.float32).reshape(bsz, L, N_GROUPS, GROUP_CH)
    lam_re = a_re.astype(jnp.float32)
    lam_im = a_im.astype(jnp.float32)
    dt = jnp.exp(log_dt.astype(jnp.float32))[:, None]
    mag = jnp.exp(lam_re * dt)
    lb_re = mag * jnp.cos(lam_im * dt)
    lb_im = mag * jnp.sin(lam_im * dt)
    den = lam_re * lam_re + lam_im * lam_im
    nr = lb_re - 1.0
    f_re = (nr * lam_re + lb_im * lam_im) / den
    f_im = (lb_im * lam_re - nr * lam_im) / den
    br = b_re.astype(jnp.float32)
    bi = b_im.astype(jnp.float32)
    bb_re = f_re[..., None] * br - f_im[..., None] * bi
    bb_im = f_re[..., None] * bi + f_im[..., None] * br
    cr = c_re.astype(jnp.float32)
    ci = c_im.astype(jnp.float32)
    ch = SCAN_CHUNK if L % SCAN_CHUNK == 0 else L
    nc = L // ch
    u_chunks = u32.reshape(bsz, nc, ch, N_GROUPS, GROUP_CH).swapaxes(0, 1)

    def combine(e1, e2):
        a1r, a1i, b1r, b1i = e1
        a2r, a2i, b2r, b2i = e2
        return (a1r * a2r - a1i * a2i, a1r * a2i + a1i * a2r,
                a2r * b1r - a2i * b1i + b2r, a2r * b1i + a2i * b1r + b2i)

    def step(carry, uc):
        h_re, h_im = carry
        bu_re = jnp.einsum('gpc,blgc->blgp', bb_re, uc)
        bu_im = jnp.einsum('gpc,blgc->blgp', bb_im, uc)
        a_r = jnp.broadcast_to(lb_re, bu_re.shape)
        a_i = jnp.broadcast_to(lb_im, bu_im.shape)
        cum_r, cum_i, loc_r, loc_i = lax.associative_scan(combine, (a_r, a_i, bu_re, bu_im), axis=1)
        xr = cum_r * h_re[:, None] - cum_i * h_im[:, None] + loc_r
        xi = cum_r * h_im[:, None] + cum_i * h_re[:, None] + loc_i
        y = jnp.einsum('gcp,blgp->blgc', cr, xr) - jnp.einsum('gcp,blgp->blgc', ci, xi)
        return (xr[:, -1], xi[:, -1]), y

    (h_re, h_im), ys = lax.scan(step, (h0_re.astype(jnp.float32), h0_im.astype(jnp.float32)), u_chunks)
    y = ys.swapaxes(0, 1).reshape(bsz, L, SSM_WIDTH) + d_skip.astype(jnp.float32) * u32.reshape(bsz, L, SSM_WIDTH)
    return y.astype(u.dtype), h_re, h_im


def s5_block(x, h0_re, h0_im, g, w_in, a_re, a_im, log_dt, b_re, b_im, c_re, c_im, d_skip, w_glu, b_glu, w_out):
    h = rms_norm(x, g)
    u, z = jnp.split(h @ w_in, 2, axis=-1)
    y, h_re, h_im = s5_scan(u, h0_re, h0_im, a_re, a_im, log_dt, b_re, b_im, c_re, c_im, d_skip)
    ga, gb = jnp.split(jax.nn.gelu(y) @ w_glu + b_glu, 2, axis=-1)
    v = ga * jax.nn.sigmoid(gb) * jax.nn.silu(z)
    return x + v @ w_out, h_re, h_im


def shared_latent(x, pos, g_in, w_dkv, g_lat):
    h = rms_norm(x, g_in)
    ckv = h @ w_dkv
    return rms_norm(ckv[..., :KV_LORA], g_lat), rope(ckv[..., KV_LORA:], pos)


def latent_attention(q_lat, q_rope, keys_lat, keys_kr, q_pos, k_pos):
    bsz, L, H, C = q_lat.shape
    qb = Q_BLOCK if L % Q_BLOCK == 0 else L
    nb = L // qb

    def to_blocks(t):
        return t.reshape((bsz, nb, qb) + t.shape[2:]).swapaxes(0, 1)

    def attend_block(args):
        ql, qr, qp = args
        s = (jnp.einsum('bqhc,bkc->bhqk', ql, keys_lat, preferred_element_type=jnp.float32)
             + jnp.einsum('bqhr,bkr->bhqk', qr, keys_kr, preferred_element_type=jnp.float32))
        s = jnp.where(k_pos[None, :] <= qp[:, None], s * SOFTMAX_SCALE, NEG_INF)
        p = jax.nn.softmax(s, axis=-1).astype(keys_lat.dtype)
        return jnp.einsum('bhqk,bkc->bqhc', p, keys_lat)

    o = lax.map(attend_block, (to_blocks(q_lat), to_blocks(q_rope), q_pos.reshape(nb, qb)))
    return o.swapaxes(0, 1).reshape(bsz, L, H, C)


def mla_block(x, q_pos, keys_lat, keys_kr, k_pos, w_uk, w_uv, g, w_in, g_q, w_uq, w_out):
    bsz, L, _ = x.shape
    h = rms_norm(x, g)
    cq_gate = h @ w_in
    cq = rms_norm(cq_gate[..., :Q_LORA], g_q)
    gate = cq_gate[..., Q_LORA:]
    q = (cq @ w_uq).reshape(bsz, L, N_HEADS, QK_NOPE + QK_ROPE)
    q_nope = q[..., :QK_NOPE]
    q_rope = rope(q[..., QK_NOPE:], q_pos)
    q_lat = jnp.einsum('blhn,chn->blhc', q_nope, w_uk.reshape(KV_LORA, N_HEADS, QK_NOPE))
    o_lat = latent_attention(q_lat, q_rope, keys_lat, keys_kr, q_pos, k_pos)
    o = jnp.einsum('blhc,chv->blhv', o_lat, w_uv.reshape(KV_LORA, N_HEADS, V_HEAD)).reshape(bsz, L, ATTN_WIDTH)
    return x + (o * jax.nn.silu(gate)) @ w_out


def setup_inputs(seed: int = 0) -> dict:
    key = jax.random.key(seed)
    ks = iter(jax.random.split(key, 48))

    def nrm(shape, scale):
        return jax.random.normal(next(ks), shape, jnp.float32) * scale

    n_pages = PAST_LEN // PAGE_SIZE
    n_used = DEC_BATCH * n_pages
    n_pool = n_used + n_used // 4
    na, nb = N_A_LAYERS, N_B_LAYERS
    x_prompt = nrm((BATCH, SEQ, D_MODEL), 1.0)
    x_sample = nrm((DEC_BATCH, DEC_SEQ, D_MODEL), 1.0)
    cache_latent = nrm((n_pool, PAGE_SIZE, KV_LORA), 1.0)
    cache_krope = nrm((n_pool, PAGE_SIZE, QK_ROPE), 1.0)
    page_table = jax.random.permutation(next(ks), n_pool)[:n_used].reshape(DEC_BATCH, n_pages).astype(jnp.int32)
    state_ssm_re = nrm((na, DEC_BATCH, N_GROUPS, STATE_DIM), 0.5)
    state_ssm_im = nrm((na, DEC_BATCH, N_GROUPS, STATE_DIM), 0.5)
    norm_a = 1.0 + nrm((na, D_MODEL), 0.02)
    w_in_a = nrm((na, D_MODEL, 2 * SSM_WIDTH), D_MODEL ** -0.5)
    a_re = -0.5 + nrm((na, N_GROUPS, STATE_DIM), 0.01)
    a_im = jnp.pi * jnp.arange(STATE_DIM, dtype=jnp.float32) + nrm((na, N_GROUPS, STATE_DIM), 0.01)
    log_dt = jax.random.uniform(next(ks), (na, N_GROUPS), jnp.float32, math.log(0.001), math.log(0.1))
    b_re = nrm((na, N_GROUPS, STATE_DIM, GROUP_CH), (2 * GROUP_CH) ** -0.5)
    b_im = nrm((na, N_GROUPS, STATE_DIM, GROUP_CH), (2 * GROUP_CH) ** -0.5)
    c_re = nrm((na, N_GROUPS, GROUP_CH, STATE_DIM), (2 * STATE_DIM) ** -0.5)
    c_im = nrm((na, N_GROUPS, GROUP_CH, STATE_DIM), (2 * STATE_DIM) ** -0.5)
    d_skip = nrm((na, SSM_WIDTH), 0.5)
    w_glu = nrm((na, SSM_WIDTH, 2 * SSM_WIDTH), SSM_WIDTH ** -0.5)
    b_glu = nrm((na, 2 * SSM_WIDTH), 0.01)
    w_out_a = nrm((na, SSM_WIDTH, D_MODEL), SSM_WIDTH ** -0.5)
    norm_kv = 1.0 + nrm((D_MODEL,), 0.02)
    w_dkv = nrm((D_MODEL, KV_LORA + QK_ROPE), D_MODEL ** -0.5)
    norm_latent = 1.0 + nrm((KV_LORA,), 0.02)
    w_uk = nrm((KV_LORA, N_HEADS * QK_NOPE), KV_LORA ** -0.5)
    w_uv = nrm((KV_LORA, N_HEADS * V_HEAD), KV_LORA ** -0.5)
    norm_b = 1.0 + nrm((nb, D_MODEL), 0.02)
    w_in_b = nrm((nb, D_MODEL, Q_LORA + ATTN_WIDTH), D_MODEL ** -0.5)
    norm_q = 1.0 + nrm((nb, Q_LORA), 0.02)
    w_uq = nrm((nb, Q_LORA, N_HEADS * (QK_NOPE + QK_ROPE)), Q_LORA ** -0.5)
    w_out_b = nrm((nb, ATTN_WIDTH, D_MODEL), ATTN_WIDTH ** -0.5)
    norm_f = 1.0 + nrm((D_MODEL,), 0.02)
    return {'x_prompt': x_prompt, 'x_sample': x_sample, 'cache_latent': cache_latent, 'cache_krope': cache_krope,
            'page_table': page_table, 'state_ssm_re': state_ssm_re, 'state_ssm_im': state_ssm_im,
            'norm_a': norm_a, 'w_in_a': w_in_a, 'a_re': a_re, 'a_im': a_im, 'log_dt': log_dt,
            'b_re': b_re, 'b_im': b_im, 'c_re': c_re, 'c_im': c_im, 'd_skip': d_skip,
            'w_glu': w_glu, 'b_glu': b_glu, 'w_out_a': w_out_a,
            'norm_kv': norm_kv, 'w_dkv': w_dkv, 'norm_latent': norm_latent, 'w_uk': w_uk, 'w_uv': w_uv,
            'norm_b': norm_b, 'w_in_b': w_in_b, 'norm_q': norm_q, 'w_uq': w_uq, 'w_out_b': w_out_b,
            'norm_f': norm_f}


def reference(x_prompt, x_sample, cache_latent, cache_krope, page_table, state_ssm_re, state_ssm_im,
              norm_a, w_in_a, a_re, a_im, log_dt, b_re, b_im, c_re, c_im, d_skip, w_glu, b_glu, w_out_a,
              norm_kv, w_dkv, norm_latent, w_uk, w_uv,
              norm_b, w_in_b, norm_q, w_uq, w_out_b, norm_f):
    n_seq, n_pages = page_table.shape
    past_len = n_pages * PAGE_SIZE
    pos_p = jnp.arange(x_prompt.shape[1], dtype=jnp.int32)
    pos_s = past_len + jnp.arange(x_sample.shape[1], dtype=jnp.int32)
    kpos_s = jnp.arange(past_len + x_sample.shape[1], dtype=jnp.int32)
    zeros_p = jnp.zeros((x_prompt.shape[0], N_GROUPS, STATE_DIM), jnp.float32)
    xp, xs = x_prompt, x_sample
    hp_re, hp_im, hs_re, hs_im = [], [], [], []
    for i in range(DEPTH):
        if i < N_A_LAYERS:
            a_par = (norm_a[i], w_in_a[i], a_re[i], a_im[i], log_dt[i], b_re[i], b_im[i],
                     c_re[i], c_im[i], d_skip[i], w_glu[i], b_glu[i], w_out_a[i])
            xp, r, m = s5_block(xp, zeros_p, zeros_p, *a_par)
            hp_re.append(r)
            hp_im.append(m)
            xs, r, m = s5_block(xs, state_ssm_re[i], state_ssm_im[i], *a_par)
            hs_re.append(r)
            hs_im.append(m)
        else:
            if i == N_A_LAYERS:
                lat_p, kr_p = shared_latent(xp, pos_p, norm_kv, w_dkv, norm_latent)
                lat_s, kr_s = shared_latent(xs, pos_s, norm_kv, w_dkv, norm_latent)
                past_lat = cache_latent[page_table].reshape(n_seq, past_len, KV_LORA)
                past_kr = cache_krope[page_table].reshape(n_seq, past_len, QK_ROPE)
                keys_lat_s = jnp.concatenate([past_lat, lat_s.astype(past_lat.dtype)], axis=1)
                keys_kr_s = jnp.concatenate([past_kr, kr_s.astype(past_kr.dtype)], axis=1)
            j = i - N_A_LAYERS
            b_par = (norm_b[j], w_in_b[j], norm_q[j], w_uq[j], w_out_b[j])
            xp = mla_block(xp, pos_p, lat_p, kr_p, pos_p, w_uk, w_uv, *b_par)
            xs = mla_block(xs, pos_s, keys_lat_s, keys_kr_s, kpos_s, w_uk, w_uv, *b_par)
    y_prompt = rms_norm(xp, norm_f)
    y_sample = rms_norm(xs, norm_f)
    return (y_prompt, y_sample, lat_p, kr_p, lat_s, kr_s,
            jnp.stack(hp_re), jnp.stack(hp_im), jnp.stack(hs_re), jnp.stack(hs_im))
```

```cpp
#include <hip/hip_runtime.h>
#include <cstdint>
#include <cstdio>

#ifndef REP_PRO
#define REP_PRO 1
#endif
#ifndef REP_G1
#define REP_G1 1
#endif
#ifndef REP_SCAN
#define REP_SCAN 1
#endif
#ifndef REP_G2
#define REP_G2 1
#endif
#ifndef REP_ATTP
#define REP_ATTP 1
#endif
#ifndef REP_ATTS
#define REP_ATTS 1
#endif
#ifndef REP_M1
#define REP_M1 1
#endif
#ifndef REP_M2
#define REP_M2 1
#endif
#ifndef REP_THIN
#define REP_THIN 1
#define REP_SK 1
#endif
#ifndef MK_ONE_LAUNCH
#define MK_ONE_LAUNCH 1
#endif

#define LAS __attribute__((address_space(3)))
typedef unsigned short bf16_t;
typedef short bf16x8 __attribute__((ext_vector_type(8)));
typedef float f32x2 __attribute__((ext_vector_type(2)));
typedef float f32x4 __attribute__((ext_vector_type(4)));
typedef float f32x16 __attribute__((ext_vector_type(16)));
typedef unsigned u32x2 __attribute__((ext_vector_type(2)));
typedef unsigned u32x4 __attribute__((ext_vector_type(4)));

constexpr int D = 1024, MP = 32768, MS = 512, M = MP + MS, SEQ = 2048;
constexpr int SSMW = 2048, NG = 128, ST = 64;
constexpr int NH = 8, KVL = 256, QL = 384, ROPE = 64;
constexpr int N1A = 1792, N1B = 1536;
constexpr int LDC1 = 1792;
constexpr int NPAGES = 64, PAGE = 128;
constexpr float EPS = 1e-6f;
constexpr float SM_SCALE_LOG2 = 0.07216878364870322f * 1.4426950408889634f;

constexpr size_t O_YP = 0, O_YS = 33554432, O_LATP = 34078720, O_KRP = 42467328, O_LATS = 44564480, O_KRS = 44695552,
                 O_HPR = 44728320, O_HPI = 44990464, O_HSR = 45252608, O_HSI = 47349760;

constexpr size_t MiB = 1u << 20;
constexpr size_t WS_CTL = 0, CTL_BYTES = 1 * MiB;
constexpr size_t WS_WIN = 2 * MiB;
constexpr size_t WS_WGLU = WS_WIN + 16 * MiB;
constexpr size_t WS_WOUT = WS_WGLU + 32 * MiB;
constexpr size_t WS_WINB = WS_WOUT + 8 * MiB;
constexpr size_t WS_WUQ = WS_WINB + 7 * MiB;
constexpr size_t WS_WUK = WS_WUQ + 3 * MiB;
constexpr size_t WS_WUV = WS_WUK + 1 * MiB;
constexpr size_t WS_WUKB = WS_WUV + 1 * MiB;
constexpr size_t WS_WOUTB = WS_WUKB + 1 * MiB;
constexpr size_t WS_ROPE = WS_WOUTB + 4 * MiB;
constexpr size_t WS_SCP = WS_ROPE + 1 * MiB;
constexpr size_t WS_SSQ2 = WS_SCP + 1 * MiB;
constexpr size_t WS_X = 80 * MiB;
constexpr size_t WS_XB = WS_X + 130 * MiB;
constexpr size_t WS_SSQ = WS_XB + 65 * MiB;
constexpr size_t WS_UZ = WS_SSQ + 3 * MiB;
constexpr size_t WS_YG = WS_UZ + 260 * MiB;
constexpr size_t WS_VB = WS_YG + 130 * MiB;
constexpr size_t WS_C1 = WS_VB + 130 * MiB;
constexpr size_t WS_CQN = WS_C1 + 114 * MiB;
constexpr size_t WS_LATB = WS_CQN + 25 * MiB;
constexpr size_t WS_KRB = WS_LATB + 17 * MiB;
constexpr size_t WS_Q = WS_KRB + 5 * MiB;
constexpr size_t WS_KN = WS_Q + 98 * MiB;
constexpr size_t WS_VT = WS_KN + 64 * MiB;
constexpr size_t WS_OG = WS_VT + 64 * MiB;
constexpr size_t WS_PART = WS_OG + 65 * MiB;
constexpr size_t WS_END = WS_PART + 9 * MiB;
constexpr int PART_STRIDE = 64 + 256 * 32;

constexpr int LDS_BYTES = 131072 + 1024;
constexpr int LDS_CTL_OFF = 131072;

typedef __bf16 bf16x2_t __attribute__((ext_vector_type(2)));
__device__ __forceinline__ unsigned pk2(float lo, float hi) { const f32x2 v = {lo, hi}; return __builtin_bit_cast(unsigned, __builtin_convertvector(v, bf16x2_t)); }
__device__ __forceinline__ float bflo(unsigned u) { return __uint_as_float(u << 16); }
__device__ __forceinline__ float bfhi(unsigned u) { return __uint_as_float(u & 0xffff0000u); }
__device__ __forceinline__ float bf1(bf16_t b) { return __uint_as_float(((unsigned)b) << 16); }
__device__ __forceinline__ bf16_t f2bf(float f) { return (bf16_t)(pk2(f, 0.f) & 0xffffu); }
__device__ __forceinline__ float wave_sum(float v) {
#pragma unroll
    for (int o = 1; o < 64; o <<= 1) v += __shfl_xor(v, o);
    return v;
}
__device__ __forceinline__ float fast_exp2(float x) { return __builtin_amdgcn_exp2f(x); }
__device__ __forceinline__ float fast_rcp(float x) { return __builtin_amdgcn_rcpf(x); }
__device__ __forceinline__ float sigmoidf_(float x) { return fast_rcp(1.0f + fast_exp2(-1.4426950408889634f * x)); }
__device__ __forceinline__ float siluf_(float x) { return x * sigmoidf_(x); }
__device__ __forceinline__ float glu3(float ga, float gb, float z) { const float e1 = fast_exp2(-1.4426950408889634f * gb), e2 = fast_exp2(-1.4426950408889634f * z); return (ga * z) * fast_rcp((1.0f + e1) * (1.0f + e2)); }
__device__ __forceinline__ float gelu_tanh(float x) { const float w = x * fmaf(x * x, -0.10294324f, -2.3022082f); return x * fast_rcp(1.0f + fast_exp2(w)); }
__device__ __forceinline__ float fma_np(float a, float b, float c) { float d; asm("v_fma_f32 %0, %1, %2, %3" : "=v"(d) : "v"(a), "v"(b), "v"(c)); return d; }
#define LDS_WAIT() asm volatile("s_waitcnt lgkmcnt(0)" ::: "memory")
#define VM_WAIT() asm volatile("s_waitcnt vmcnt(0)" ::: "memory")
#define WG_BAR() do { asm volatile("s_waitcnt lgkmcnt(0)" ::: "memory"); __builtin_amdgcn_s_barrier(); asm volatile("" ::: "memory"); } while (0)

namespace pg8 {
#define PG8_LAS __attribute__((address_space(3)))
constexpr int BM = 256, BK = 64, HALF = 128, HTB = HALF * BK * 2, STAGE_BYTES = 8 * HTB, NXCD = 8, WGM = 8;
__host__ __device__ __forceinline__ int lds_byte(int r, int c) { const int st = (r >> 4) * 2 + (c >> 5), rr = r & 15, cc = c & 31, ob = rr * 64 + cc * 2; return st * 1024 + (ob ^ (((ob >> 9) & 1) << 5)); }
__host__ __device__ __forceinline__ void stage_rc(int b, int& R, int& C) { const int st = b / 1024, sb = b % 1024, swz = sb ^ (((sb >> 9) & 1) << 5); R = (st >> 1) * 16 + swz / 64; C = (st & 1) * 32 + (swz % 64) / 2; }
__host__ __device__ __forceinline__ int perm32(int rho) { const int n = rho >> 4, i = rho & 15; return 8 * (i >> 2) + 4 * n + (i & 3); }
struct Unit { int pm, pn; };
struct Gemm { const bf16_t* A; const bf16_t* Bt; int M, N, K; int lda = 0; };
struct StaticOrder {
    int nM, nN, nwg, G, c;
    __host__ __device__ void init(int M_, int N_, int G_, int c_) { nM = M_ / BM; nN = N_ / BM; nwg = nM * nN; G = G_; c = c_; }
    __host__ __device__ bool next(int i, Unit& u) const {
        const long L = (long)i * G + c; if (L >= nwg) return false;
        int wgid = (int)L; { const int q = nwg / NXCD, r = nwg % NXCD, xcd = wgid % NXCD, off = wgid / NXCD; wgid = (xcd < r ? xcd * (q + 1) : r * (q + 1) + (xcd - r) * q) + off; }
        const int nig = WGM * nN, gid = wgid / nig, fm = gid * WGM, gsz = (nM - fm) < WGM ? (nM - fm) : WGM;
        u.pm = fm + ((wgid % nig) % gsz); u.pn = (wgid % nig) / gsz; return true;
    }
    __device__ __forceinline__ void a_ready(const Unit&) const {}
    __device__ __forceinline__ void done(const Unit&) const {}
};

template <bool HAS_SSQ, int LAYOUT = 0, bool EMIT = false> struct EpiScale {
    static constexpr bool PERM = true, AFTER_DRAIN = false;
    bf16_t* O; int ldc; const float* ssq; float invk; float* sq2 = nullptr;
    __device__ __forceinline__ void operator()(const f32x4 (&acc)[2][2][4][2], const Unit& u, int wr, int wc, int fr, int fq) const {
        const int row0 = u.pm * BM + wr * 64 + fr, col0 = u.pn * BM + wc * 32 + 8 * fq;
        float rr[8];
        if constexpr (HAS_SSQ) {
            f32x4 pv[8];
#pragma unroll
            for (int i = 0; i < 8; ++i) pv[i] = *(const f32x4*)(ssq + (size_t)(row0 + (i >> 2) * HALF + (i & 3) * 16) * 16 + 4 * fq);
#pragma unroll
            for (int i = 0; i < 8; ++i) { float s = (pv[i].x + pv[i].y) + (pv[i].z + pv[i].w); s += __shfl_xor(s, 16); s += __shfl_xor(s, 32); rr[i] = __builtin_amdgcn_rsqf(s * invk + EPS); }
        }
#pragma unroll
        for (int ai = 0; ai < 2; ++ai)
#pragma unroll
            for (int m = 0; m < 4; ++m) {
                const int row = row0 + ai * HALF + m * 16; const float r = HAS_SSQ ? rr[ai * 4 + m] : 1.f;
                if constexpr (EMIT) { if (u.pn < 2) {
                    const f32x4 a0 = acc[ai][0][m][0] * r, a1 = acc[ai][0][m][1] * r, b0 = acc[ai][1][m][0] * r, b1 = acc[ai][1][m][1] * r;
                    float s0 = ((a0[0] * a0[0] + a0[1] * a0[1]) + (a0[2] * a0[2] + a0[3] * a0[3])) + ((a1[0] * a1[0] + a1[1] * a1[1]) + (a1[2] * a1[2] + a1[3] * a1[3]));
                    float s1 = ((b0[0] * b0[0] + b0[1] * b0[1]) + (b0[2] * b0[2] + b0[3] * b0[3])) + ((b1[0] * b1[0] + b1[1] * b1[1]) + (b1[2] * b1[2] + b1[3] * b1[3]));
                    s0 += __shfl_xor(s0, 16); s1 += __shfl_xor(s1, 16); s0 += __shfl_xor(s0, 32); s1 += __shfl_xor(s1, 32);
                    if (fq == 0) { float* q2 = sq2 + (size_t)row * 16; if (u.pn == 0) q2[wc] = s0 + s1; else { q2[4 + wc] = s0; q2[8 + wc] = 0.f; q2[12 + wc] = 0.f; } } } }
#pragma unroll
                for (int bj = 0; bj < 2; ++bj) { const f32x4 v0 = acc[ai][bj][m][0] * r, v1 = acc[ai][bj][m][1] * r;
                    u32x4 w; w.x = pk2(v0[0], v0[1]); w.y = pk2(v0[2], v0[3]); w.z = pk2(v1[0], v1[1]); w.w = pk2(v1[2], v1[3]);
                    const int col = col0 + bj * HALF; size_t off;
                    if (LAYOUT == 0) off = (size_t)row * ldc + col;
                    else if (LAYOUT == 1) off = ((size_t)((row >> 11) * 8 + (col >> 7)) * 2048 + (row & 2047)) * 128 + (col & 127);
                    else off = ((size_t)(((col >> 11) * 8 + (row >> 7)) * 32 + ((col >> 6) & 31)) * 128 + (row & 127)) * 64 + (col & 63);
                    *(u32x4*)(O + off) = w; }
            }
    }
};
struct EpiGlu {
    static constexpr bool PERM = true, AFTER_DRAIN = false;
    bf16_t* V; const bf16_t* UZ; const float* bias;
    __device__ __forceinline__ void operator()(const f32x4 (&acc)[2][2][4][2], const Unit& u, int wr, int wc, int fr, int fq) const {
        const int row0 = u.pm * BM + wr * 64 + fr, j0 = u.pn * HALF + wc * 32 + 8 * fq;
        const f32x4 ba0 = *(const f32x4*)(bias + j0), ba1 = *(const f32x4*)(bias + j0 + 4), bb0 = *(const f32x4*)(bias + SSMW + j0), bb1 = *(const f32x4*)(bias + SSMW + j0 + 4);
        u32x4 zz[8];
#pragma unroll
        for (int i = 0; i < 8; ++i) zz[i] = *(const u32x4*)(UZ + (size_t)(row0 + (i >> 2) * HALF + (i & 3) * 16) * 4096 + SSMW + j0);
#pragma unroll
        for (int ai = 0; ai < 2; ++ai)
#pragma unroll
            for (int m = 0; m < 4; ++m) {
                const int row = row0 + ai * HALF + m * 16;
                const u32x4 zr = zz[ai * 4 + m];
                const f32x4 ga0 = acc[ai][0][m][0] + ba0, ga1 = acc[ai][0][m][1] + ba1, gb0 = acc[ai][1][m][0] + bb0, gb1 = acc[ai][1][m][1] + bb1;
                float z[8] = {bflo(zr.x), bfhi(zr.x), bflo(zr.y), bfhi(zr.y), bflo(zr.z), bfhi(zr.z), bflo(zr.w), bfhi(zr.w)};
                float o[8];
#pragma unroll
                for (int e = 0; e < 4; ++e) { o[e] = glu3(ga0[e], gb0[e], z[e]); o[4 + e] = glu3(ga1[e], gb1[e], z[4 + e]); }
                u32x4 w; w.x = pk2(o[0], o[1]); w.y = pk2(o[2], o[3]); w.z = pk2(o[4], o[5]); w.w = pk2(o[6], o[7]);
                *(u32x4*)(V + (size_t)row * SSMW + j0) = w;
            }
    }
};
struct EpiRes {
    static constexpr bool PERM = true, AFTER_DRAIN = false;
    float* X; bf16_t* XB; float* SSQ; const float* xin_p; const float* xin_s;
    __device__ __forceinline__ void operator()(const f32x4 (&acc)[2][2][4][2], const Unit& u, int wr, int wc, int fr, int fq) const {
        const int row0 = u.pm * BM + wr * 64 + fr, col0 = u.pn * BM + wc * 32 + 8 * fq;
#pragma unroll
        for (int ai = 0; ai < 2; ++ai) {
            u32x4 xo[4][2];
#pragma unroll
            for (int m = 0; m < 4; ++m) { const bf16_t* xs = XB + (size_t)(row0 + ai * HALF + m * 16) * D + col0;
#pragma unroll
                for (int bj = 0; bj < 2; ++bj) xo[m][bj] = *(const u32x4*)(xs + bj * HALF); }
#pragma unroll
            for (int m = 0; m < 4; ++m) {
                const int row = row0 + ai * HALF + m * 16; float ss = 0.f;
                bf16_t* xb = XB + (size_t)row * D + col0;
#pragma unroll
                for (int bj = 0; bj < 2; ++bj) { const u32x4 xr_ = xo[m][bj];
                    f32x4 x0, x1; x0[0] = bflo(xr_.x); x0[1] = bfhi(xr_.x); x0[2] = bflo(xr_.y); x0[3] = bfhi(xr_.y); x1[0] = bflo(xr_.z); x1[1] = bfhi(xr_.z); x1[2] = bflo(xr_.w); x1[3] = bfhi(xr_.w);
                    const f32x4 o0 = x0 + acc[ai][bj][m][0], o1 = x1 + acc[ai][bj][m][1];
                    u32x4 w; w.x = pk2(o0[0], o0[1]); w.y = pk2(o0[2], o0[3]); w.z = pk2(o1[0], o1[1]); w.w = pk2(o1[2], o1[3]); *(u32x4*)(xb + bj * HALF) = w;
                    ss += ((o0[0] * o0[0] + o0[1] * o0[1]) + (o0[2] * o0[2] + o0[3] * o0[3])) + ((o1[0] * o1[0] + o1[1] * o1[1]) + (o1[2] * o1[2] + o1[3] * o1[3])); }
                ss += __shfl_xor(ss, 16); ss += __shfl_xor(ss, 32);
                if (fq == 0) SSQ[(size_t)row * 16 + u.pn * 4 + wc] = ss;
            }
        }
    }
};

template <class Epi, class Sched, bool ALIGN_EPI = false, bool SP2 = false>
__device__ __forceinline__ void gemm_phase(PG8_LAS unsigned char* lds, const Gemm g, const Sched& S, const Epi& E) {
    int tid_ = threadIdx.x; asm volatile("" : "+v"(tid_));
    const int tid = tid_, wid = __builtin_amdgcn_readfirstlane(tid >> 6), lane = tid & 63, wr = wid >> 2, wc = wid & 3, fr = lane & 15, fq = lane >> 4;
    const int K = g.K, nt = K / BK, lda = g.lda ? g.lda : K;
    unsigned voffA[2], voffB[2];
#pragma unroll
    for (int i = 0; i < 2; ++i) { int R, C; stage_rc(tid * 16 + i * 8192, R, C); const int Rb = Epi::PERM ? ((R & ~31) + perm32(R & 31)) : R;
        voffA[i] = (unsigned)(R * lda + C) * 2u; voffB[i] = (unsigned)(Rb * K + C) * 2u; }
    const size_t kstep = (size_t)(BK * 2);
    const size_t hstep = (size_t)HALF * K * 2;
    const size_t tstep = 2 * hstep;
    const size_t hstepA = (size_t)HALF * lda * 2, tstepA = 2 * hstepA;
    const unsigned ldsw = (unsigned)wid * 1024u;
    const int aoff = lds_byte(wr * 64 + fr, fq * 8), boff = lds_byte(wc * 32 + fr, fq * 8);
#define PG8_SA(b, h) (((b) * 2 + (h)) * HTB)
#define PG8_SB(b, h) ((4 + (b) * 2 + (h)) * HTB)
#define PG8_STAGE(bufoff, gbase, voff) do { _Pragma("unroll") for (int _i = 0; _i < 2; ++_i) \
        __builtin_amdgcn_global_load_lds((const unsigned*)((const char*)(gbase) + (voff)[_i]), (PG8_LAS unsigned*)(lds + (bufoff) + ldsw + _i * 8192), 16, 0, 0); } while (0)
#define PG8_LDA(dst, b, h) do { _Pragma("unroll") for (int m = 0; m < 4; ++m) _Pragma("unroll") for (int k = 0; k < 2; ++k) dst[m][k] = *(const PG8_LAS bf16x8*)(lds + PG8_SA(b, h) + aoff + m * 2048 + k * 1024); } while (0)
#define PG8_LDB(dst, b, h) do { _Pragma("unroll") for (int n = 0; n < 2; ++n) _Pragma("unroll") for (int k = 0; k < 2; ++k) dst[n][k] = *(const PG8_LAS bf16x8*)(lds + PG8_SB(b, h) + boff + n * 2048 + k * 1024); } while (0)
#define PG8_MMA(ai, bj, At, Bt) do { __builtin_amdgcn_s_setprio(1); _Pragma("unroll") for (int m = 0; m < 4; ++m) _Pragma("unroll") for (int n = 0; n < 2; ++n) _Pragma("unroll") for (int k = 0; k < 2; ++k) \
        acc[ai][bj][m][n] = __builtin_amdgcn_mfma_f32_16x16x32_bf16(Bt[n][k], At[m][k], acc[ai][bj][m][n], 0, 0, 0); __builtin_amdgcn_s_setprio(0); } while (0)
#define PG8_WAIT_V(n) asm volatile("s_waitcnt vmcnt(" #n ")" ::: "memory")
#define PG8_WAIT_L(n) asm volatile("s_waitcnt lgkmcnt(" #n ")" ::: "memory")
#define PG8_BAR __builtin_amdgcn_s_barrier()
#define PG8_SCHED __builtin_amdgcn_sched_barrier(0)
    Unit cur, nxt; int ui = 0;
    if (!S.next(0, cur)) return;
    f32x4 acc[2][2][4][2];
#pragma unroll
    for (int a = 0; a < 2; ++a)
#pragma unroll
        for (int b = 0; b < 2; ++b)
#pragma unroll
            for (int m = 0; m < 4; ++m)
#pragma unroll
                for (int n = 0; n < 2; ++n) acc[a][b][m][n] = (f32x4){0.f, 0.f, 0.f, 0.f};
    bf16x8 At[4][2], B0[2][2], B1[2][2];
    const char* cA = (const char*)g.A + (size_t)cur.pm * tstepA; const char* cB = (const char*)g.Bt + (size_t)cur.pn * tstep;
    S.a_ready(cur);
    if constexpr (SP2) {
        PG8_STAGE(PG8_SB(0, 0), cB, voffB); PG8_STAGE(PG8_SB(0, 1), cB + hstep, voffB); PG8_STAGE(PG8_SA(0, 0), cA, voffA); PG8_STAGE(PG8_SA(0, 1), cA + hstepA, voffA);
        if (wr == 1) PG8_BAR;
        PG8_WAIT_V(2); PG8_BAR;
        PG8_STAGE(PG8_SB(1, 0), cB + kstep, voffB); PG8_STAGE(PG8_SA(1, 0), cA + kstep, voffA); PG8_STAGE(PG8_SB(1, 1), cB + hstep + kstep, voffB);
        PG8_WAIT_V(6); PG8_BAR;
    } else {
        PG8_STAGE(PG8_SB(0, 0), cB, voffB); PG8_STAGE(PG8_SA(0, 0), cA, voffA); PG8_STAGE(PG8_SB(0, 1), cB + hstep, voffB); PG8_STAGE(PG8_SA(0, 1), cA + hstepA, voffA);
        if (wr == 1) PG8_BAR;
        PG8_WAIT_V(4); PG8_BAR;
        PG8_STAGE(PG8_SB(1, 0), cB + kstep, voffB); PG8_STAGE(PG8_SA(1, 0), cA + kstep, voffA); PG8_STAGE(PG8_SB(1, 1), cB + hstep + kstep, voffB);
        PG8_WAIT_V(6); PG8_BAR;
    }
    for (;;) {
        const bool has_next = S.next(ui + 1, nxt);
        const char* nA = has_next ? (const char*)g.A + (size_t)nxt.pm * tstepA : cA; const char* nB = has_next ? (const char*)g.Bt + (size_t)nxt.pn * tstep : cB;
#pragma nounroll
        for (int t = 0; t < nt; t += 2) {
            const bool last = (t == nt - 2);
            const char* a1 = cA + (size_t)(t + 1) * kstep;
            const char* a2 = last ? nA : cA + (size_t)(t + 2) * kstep; const char* b2 = last ? nB : cB + (size_t)(t + 2) * kstep;
            const char* a3 = a2 + kstep; const char* b3 = b2 + kstep;
            if (last && has_next) S.a_ready(nxt);
            if constexpr (SP2) {
            PG8_LDB(B0, 0, 0); PG8_LDB(B1, 0, 1); PG8_SCHED; PG8_LDA(At, 0, 0); PG8_STAGE(PG8_SA(1, 1), a1 + hstepA, voffA);
            PG8_WAIT_V(8); PG8_WAIT_L(0); PG8_BAR; PG8_MMA(0, 0, At, B0); PG8_MMA(0, 1, At, B1); PG8_BAR; PG8_SCHED;
            PG8_LDA(At, 0, 1); PG8_STAGE(PG8_SB(0, 0), b2, voffB); PG8_STAGE(PG8_SB(0, 1), b2 + hstep, voffB); PG8_STAGE(PG8_SA(0, 0), a2, voffA);
            PG8_WAIT_V(8); PG8_WAIT_L(0); PG8_BAR; PG8_MMA(1, 0, At, B0); PG8_MMA(1, 1, At, B1); PG8_BAR; PG8_SCHED;
            PG8_LDB(B0, 1, 0); PG8_LDB(B1, 1, 1); PG8_SCHED; PG8_LDA(At, 1, 0); PG8_STAGE(PG8_SA(0, 1), a2 + hstepA, voffA);
            PG8_WAIT_V(8); PG8_WAIT_L(0); PG8_BAR; PG8_MMA(0, 0, At, B0); PG8_MMA(0, 1, At, B1); PG8_BAR; PG8_SCHED;
            PG8_LDA(At, 1, 1); PG8_STAGE(PG8_SB(1, 0), b3, voffB); PG8_STAGE(PG8_SB(1, 1), b3 + hstep, voffB); PG8_STAGE(PG8_SA(1, 0), a3, voffA);
            PG8_WAIT_V(8); PG8_WAIT_L(0); PG8_BAR; PG8_MMA(1, 0, At, B0); PG8_MMA(1, 1, At, B1); PG8_BAR; PG8_SCHED;
            } else {
            PG8_LDB(B0, 0, 0); PG8_SCHED; PG8_LDA(At, 0, 0); PG8_STAGE(PG8_SA(1, 1), a1 + hstepA, voffA);
            PG8_WAIT_L(8); PG8_BAR; PG8_WAIT_L(0); PG8_MMA(0, 0, At, B0); PG8_BAR; PG8_SCHED;
            PG8_LDB(B1, 0, 1); PG8_STAGE(PG8_SB(0, 0), b2, voffB);
            PG8_BAR; PG8_WAIT_L(0); PG8_MMA(0, 1, At, B1); PG8_BAR;
            PG8_LDA(At, 0, 1); PG8_STAGE(PG8_SA(0, 0), a2, voffA);
            PG8_BAR; PG8_WAIT_L(0); PG8_MMA(1, 0, At, B0); PG8_BAR; PG8_SCHED;
            PG8_STAGE(PG8_SB(0, 1), b2 + hstep, voffB);
            PG8_WAIT_V(6); PG8_BAR; PG8_MMA(1, 1, At, B1); PG8_BAR;
            PG8_LDB(B0, 1, 0); PG8_SCHED; PG8_LDA(At, 1, 0); PG8_STAGE(PG8_SA(0, 1), a2 + hstepA, voffA);
            PG8_WAIT_L(8); PG8_BAR; PG8_WAIT_L(0); PG8_MMA(0, 0, At, B0); PG8_BAR; PG8_SCHED;
            PG8_LDB(B1, 1, 1); PG8_STAGE(PG8_SB(1, 0), b3, voffB);
            PG8_BAR; PG8_WAIT_L(0); PG8_MMA(0, 1, At, B1); PG8_BAR;
            PG8_LDA(At, 1, 1); PG8_STAGE(PG8_SA(1, 0), a3, voffA);
            PG8_BAR; PG8_WAIT_L(0); PG8_MMA(1, 0, At, B0); PG8_BAR; PG8_SCHED;
            PG8_STAGE(PG8_SB(1, 1), b3 + hstep, voffB);
            PG8_WAIT_V(6); PG8_BAR; PG8_MMA(1, 1, At, B1); PG8_BAR;
            }
        }
        if constexpr (ALIGN_EPI) { if (wr == 0) PG8_BAR; }
        if constexpr (!Epi::AFTER_DRAIN) { E(acc, cur, wr, wc, fr, fq); S.done(cur); }
        if (!has_next) break;
#pragma unroll
        for (int a = 0; a < 2; ++a)
#pragma unroll
            for (int b = 0; b < 2; ++b)
#pragma unroll
                for (int m = 0; m < 4; ++m)
#pragma unroll
                    for (int n = 0; n < 2; ++n) acc[a][b][m][n] = (f32x4){0.f, 0.f, 0.f, 0.f};
        cur = nxt; cA = nA; cB = nB; ++ui;
        if constexpr (ALIGN_EPI) { if (wr == 1) PG8_BAR; }
    }
    PG8_WAIT_V(0);
    if constexpr (!ALIGN_EPI) { if (wr == 0) PG8_BAR; }
    PG8_BAR;
#undef PG8_SA
#undef PG8_SB
#undef PG8_STAGE
#undef PG8_LDA
#undef PG8_LDB
#undef PG8_MMA
#undef PG8_WAIT_V
#undef PG8_WAIT_L
#undef PG8_BAR
#undef PG8_SCHED
}
}

namespace sk {
constexpr int PITCH = 272, ABYTES = 128 * PITCH, BBYTES = 64 * PITCH, STG = ABYTES + BBYTES;
template <bool HAS_SSQ, bool EMIT = false> struct SkScale {
    bf16_t* O; int ldc; const float* ssq; float invk; float* sq2 = nullptr;
    __device__ __forceinline__ int brow_src(int nc, int brow) const { return nc * 64 + brow; }
    __device__ __forceinline__ void operator()(const f32x16& acc, int mr, int nc, int wr, int wc, int li, int kh, LAS unsigned char*) const {
        const size_t grow = (size_t)MP + mr * 128 + 32 * wr + li; float r = 1.f;
        if constexpr (HAS_SSQ) { const f32x4* sp = (const f32x4*)(ssq + grow * 16); const f32x4 p0 = sp[0], p1 = sp[1], p2 = sp[2], p3 = sp[3];
            r = __builtin_amdgcn_rsqf((((p0.x + p0.y) + (p0.z + p0.w)) + ((p1.x + p1.y) + (p1.z + p1.w)) + ((p2.x + p2.y) + (p2.z + p2.w)) + ((p3.x + p3.y) + (p3.z + p3.w))) * invk + EPS); }
        if constexpr (EMIT) { if (nc < 6) { float s = 0.f;
#pragma unroll
            for (int q = 0; q < 16; ++q) { const float t = acc[q] * r; s += t * t; }
            s += __shfl_xor(s, 32);
            if (kh == 0) { float* q2 = sq2 + grow * 16; q2[2 * nc + wc] = s; if (nc == 5) { float z0_ = 0.f; asm volatile("" : "+v"(z0_)); q2[12 + 2 * wc] = z0_; q2[13 + 2 * wc] = z0_; }     } } }
#pragma unroll
        for (int q = 0; q < 4; ++q) { u32x2 o; o.x = pk2(acc[4 * q] * r, acc[4 * q + 1] * r); o.y = pk2(acc[4 * q + 2] * r, acc[4 * q + 3] * r);
            *(u32x2*)(O + grow * ldc + nc * 64 + 32 * wc + 8 * q + 4 * kh) = o; }
    }
};
struct SkGlu {
    bf16_t* V; const bf16_t* UZ; const float* bias;
    __device__ __forceinline__ int brow_src(int nc, int brow) const { const int wcb = brow >> 5, c = brow & 31, q = c >> 3, hi = (c >> 2) & 1, e = c & 3;
        const int j = 32 * nc + 16 * wcb + 8 * (q >> 1) + 4 * hi + e, bj = q & 1; return 256 * (j >> 7) + 128 * bj + (j & 127); }
    __device__ __forceinline__ void operator()(const f32x16& acc, int mr, int nc, int wr, int wc, int li, int kh, LAS unsigned char*) const {
        const size_t grow = (size_t)MP + mr * 128 + 32 * wr + li;
#pragma unroll
        for (int p = 0; p < 2; ++p) { const int j0 = 32 * nc + 16 * wc + 8 * p + 4 * kh;
            const f32x4 ba = *(const f32x4*)(bias + j0), bb = *(const f32x4*)(bias + SSMW + j0);
            const u32x2 zr = *(const u32x2*)(UZ + grow * 4096 + SSMW + j0);
            const float z[4] = {bflo(zr.x), bfhi(zr.x), bflo(zr.y), bfhi(zr.y)}; float o[4];
#pragma unroll
            for (int e = 0; e < 4; ++e) o[e] = glu3(acc[8 * p + e] + ba[e], acc[8 * p + 4 + e] + bb[e], z[e]);
            u32x2 w; w.x = pk2(o[0], o[1]); w.y = pk2(o[2], o[3]); *(u32x2*)(V + grow * SSMW + j0) = w; }
    }
};
struct SkRes {
    float* X; bf16_t* XB; float* SSQ; const float* xin_s;
    __device__ __forceinline__ int brow_src(int nc, int brow) const { return nc * 64 + brow; }
    __device__ __forceinline__ void operator()(const f32x16& acc, int mr, int nc, int wr, int wc, int li, int kh, LAS unsigned char* lds) const {
        const size_t grow = (size_t)MP + mr * 128 + 32 * wr + li; const int col0 = nc * 64 + 32 * wc + 4 * kh;
        const bf16_t* xs = XB + grow * D + col0;
        u32x2 xo[4];
#pragma unroll
        for (int q = 0; q < 4; ++q) xo[q] = *(const u32x2*)(xs + 8 * q);
        float ss = 0.f;
#pragma unroll
        for (int q = 0; q < 4; ++q) { f32x4 o; o.x = bflo(xo[q].x) + acc[4 * q]; o.y = bfhi(xo[q].x) + acc[4 * q + 1]; o.z = bflo(xo[q].y) + acc[4 * q + 2]; o.w = bfhi(xo[q].y) + acc[4 * q + 3];
            u32x2 w; w.x = pk2(o.x, o.y); w.y = pk2(o.z, o.w); *(u32x2*)(XB + grow * D + col0 + 8 * q) = w;
            ss += (o.x * o.x + o.y * o.y) + (o.z * o.z + o.w * o.w); }
        ss += __shfl_xor(ss, 32);
        LAS float* part = (LAS float*)lds;
        if (wc == 1 && kh == 0) part[32 * wr + li] = ss;
        WG_BAR();
        if (wc == 0 && kh == 0) SSQ[grow * 16 + nc] = ss + part[32 * wr + li];
    }
};
template <class Epi>
__device__ __forceinline__ void gemm(LAS unsigned char* lds, const bf16_t* A, const bf16_t* Bt, int K, int nU, const Epi& E, int wg, int G, int lda_ = 0) {
    int tid_ = threadIdx.x; asm volatile("" : "+v"(tid_));
    const int tid = tid_, lane = tid & 63, w = __builtin_amdgcn_readfirstlane(tid >> 6), wr = w >> 1, wc = w & 1, li = lane & 31, kh = lane >> 5;
    const int ns = K >> 7, lda = lda_ ? lda_ : K;
    for (int it = wg; it < 4 * nU; it += G) {
        const int full_ = (nU & ~7) * 4, rem_ = nU & 7;
        int mr, nc;
        if (it < full_) { const int idx_ = it >> 3; mr = idx_ & 3; nc = (it & 7) + 8 * (idx_ >> 2); }
        else { const int r_ = it - full_; nc = (nU & ~7) + r_ % rem_; mr = r_ / rem_; }
        const bf16_t* ga = A + (size_t)(mr * 128 + (tid >> 4)) * lda + (tid & 15) * 8;
        const bf16_t* gb0 = Bt + (size_t)E.brow_src(nc, tid >> 4) * K + (tid & 15) * 8;
        const bf16_t* gb1 = Bt + (size_t)E.brow_src(nc, (tid >> 4) + 32) * K + (tid & 15) * 8;
        const int la = (tid >> 4) * PITCH + (tid & 15) * 16, lb = ABYTES + la;
        u32x4 raA[4], rbA[2], raB[4], rbB[2];
#define SK_LOAD(ra, rb, k0) do { _Pragma("unroll") for (int i_ = 0; i_ < 4; ++i_) ra[i_] = *(const u32x4*)(ga + (size_t)(32 * i_) * lda + (k0)); rb[0] = *(const u32x4*)(gb0 + (k0)); rb[1] = *(const u32x4*)(gb1 + (k0)); } while (0)
#define SK_STORE(ra, rb, buf) do { LAS unsigned char* sb_ = lds + (buf) * STG; _Pragma("unroll") for (int i_ = 0; i_ < 4; ++i_) *(LAS u32x4*)(sb_ + la + 32 * i_ * PITCH) = ra[i_]; \
        *(LAS u32x4*)(sb_ + lb) = rb[0]; *(LAS u32x4*)(sb_ + lb + 32 * PITCH) = rb[1]; } while (0)
#define SK_COMPUTE(s) do { const LAS unsigned char* sa_ = lds + ((s) & 1) * STG + (32 * wr + li) * PITCH + kh * 16; const LAS unsigned char* sbb_ = lds + ((s) & 1) * STG + ABYTES + (32 * wc + li) * PITCH + kh * 16; \
        _Pragma("unroll") for (int ks = 0; ks < 8; ++ks) { const bf16x8 bf = *(const LAS bf16x8*)(sbb_ + ks * 32); const bf16x8 af = *(const LAS bf16x8*)(sa_ + ks * 32); \
            acc = __builtin_amdgcn_mfma_f32_32x32x16_bf16(bf, af, acc, 0, 0, 0); } } while (0)
        f32x16 acc;
#pragma unroll
        for (int r = 0; r < 16; ++r) acc[r] = 0.f;
        SK_LOAD(raA, rbA, 0); SK_LOAD(raB, rbB, 128);
        SK_STORE(raA, rbA, 0); WG_BAR();
        for (int s = 0; s < ns; s += 2) {
            if (s + 2 < ns) SK_LOAD(raA, rbA, (s + 2) * 128);
            __builtin_amdgcn_sched_barrier(0);
            SK_COMPUTE(s);
            if (s + 1 < ns) SK_STORE(raB, rbB, 1);
            WG_BAR();
            if (s + 1 < ns) {
                if (s + 3 < ns) SK_LOAD(raB, rbB, (s + 3) * 128);
                __builtin_amdgcn_sched_barrier(0);
                SK_COMPUTE(s + 1);
                if (s + 2 < ns) SK_STORE(raA, rbA, 0);
                WG_BAR();
            }
        }
#undef SK_LOAD
#undef SK_STORE
#undef SK_COMPUTE
        E(acc, mr, nc, wr, wc, li, kh, lds);
        WG_BAR();
    }
}
}

#define XB_TMO      128
#define XB_XCNT(j)  (256  + 64 * (j))
#define XB_XSUB(j)  (1280 + 64 * (j))
#define XB_XGEN(j)  (2304 + 64 * (j))
#define XB_TOP      3328
#define XB_TOPGEN   3392
#define XCD_BAR_WORDS 3456
#define XB_SPIN_CAP (1u << 18)
__device__ __forceinline__ unsigned xb_ld(unsigned* p)              { return __hip_atomic_load(p, __ATOMIC_RELAXED, __HIP_MEMORY_SCOPE_AGENT); }
__device__ __forceinline__ unsigned xb_add(unsigned* p, unsigned v) { return __hip_atomic_fetch_add(p, v, __ATOMIC_RELAXED, __HIP_MEMORY_SCOPE_AGENT); }
__device__ __forceinline__ unsigned xb_xcc_id() { return (unsigned)__builtin_amdgcn_s_getreg((3 << 11) | 20) & 0xFu; }
#define XB_SPIN(cond, bar) do { unsigned _sp = 0; while (cond) { __builtin_amdgcn_s_sleep(1); \
    if ((++_sp & 255u) == 0u) { if (xb_ld(&(bar)[XB_TMO])) break; if (_sp > XB_SPIN_CAP) { atomicAdd(&(bar)[XB_TMO], 1u); break; } } } } while (0)
struct XcdBarrier { unsigned* bar; unsigned x; volatile LAS unsigned* st; };
__device__ __forceinline__ XcdBarrier xcd_barrier_post(unsigned* bar, volatile LAS unsigned* st) {
    XcdBarrier b; b.bar = bar; b.x = xb_xcc_id(); b.st = st;
    if (threadIdx.x == 0) (void)xb_add(&bar[XB_XCNT(b.x)], 1u);
    return b;
}
__device__ __forceinline__ void xcd_barrier_complete(unsigned* bar, unsigned x, unsigned& nloc, unsigned& nx) {
    const unsigned G = gridDim.x * gridDim.y * gridDim.z;
    unsigned sum, cnt, mine, sp = 0u;
    for (;;) {
        sum = 0u; cnt = 0u; mine = 0u;
#pragma unroll
        for (unsigned j = 0; j < 16; ++j) { const unsigned c = xb_ld(&bar[XB_XCNT(j)]); sum += c; cnt += (c > 0u) ? 1u : 0u; mine = (j == x) ? c : mine; }
        if (sum == G) break;
        __builtin_amdgcn_s_sleep(1);
        if ((++sp & 255u) == 0u) { if (xb_ld(&bar[XB_TMO])) break; if (sp > XB_SPIN_CAP) { atomicAdd(&bar[XB_TMO], 1u); break; } }
    }
    nloc = mine > 0u ? mine : 1u; nx = cnt > 0u ? cnt : 1u;
}
__device__ __forceinline__ void xcd_barrier(const XcdBarrier& b) {
    asm volatile("s_waitcnt vmcnt(0)" ::: "memory");
    __syncthreads();
    if (threadIdx.x == 0) {
        unsigned* bar = b.bar;
        __builtin_amdgcn_s_waitcnt(0);
        unsigned nloc = b.st[0], nx = b.st[1];
        if (nloc == 0u) { xcd_barrier_complete(bar, b.x, nloc, nx); b.st[0] = nloc; b.st[1] = nx; }
        const unsigned old = xb_add(&bar[XB_XSUB(b.x)], 1u);
        const unsigned gen = old / nloc;
        if (old + 1u == (gen + 1u) * nloc) {
            __builtin_amdgcn_fence(__ATOMIC_RELEASE, "agent");
            asm volatile("s_waitcnt vmcnt(0)" ::: "memory");
            const unsigned og = xb_add(&bar[XB_TOP], 1u);
            if (og + 1u < (gen + 1u) * nx) XB_SPIN(xb_ld(&bar[XB_TOP]) < (gen + 1u) * nx, bar);
        } else {
            XB_SPIN(xb_ld(&bar[XB_TOP]) < (gen + 1u) * nx, bar);
        }
        __builtin_amdgcn_fence(__ATOMIC_ACQUIRE, "agent");
        asm volatile("s_waitcnt vmcnt(0)" ::: "memory");
    }
    __syncthreads();
}

struct Args {
    const float* x_prompt; const float* x_sample; const float* cache_latent; const float* cache_krope; const int* page_table;
    const float* state_re; const float* state_im;
    const float* norm_a; const float* w_in_a; const float* a_re; const float* a_im; const float* log_dt; const float* b_re; const float* b_im;
    const float* c_re; const float* c_im; const float* d_skip; const float* w_glu; const float* b_glu; const float* w_out_a;
    const float* norm_kv; const float* w_dkv; const float* norm_latent; const float* w_uk; const float* w_uv;
    const float* norm_b; const float* w_in_b; const float* norm_q; const float* w_uq; const float* w_out_b; const float* norm_f;
    float* out; unsigned char* ws; int ph_lo, ph_hi;
};

__device__ __forceinline__ void tr_item(const float* __restrict__ W, int ldw, const float* __restrict__ gain, bf16_t* WT, int K, int drow0, int k0, int n0, LAS float* scr, int lane) {
    {
        f32x4 v[8]; float gk[8];
#pragma unroll
        for (int i = 0; i < 8; ++i) { const int kk = 8 * i + (lane >> 3); v[i] = *(const f32x4*)(W + (size_t)(k0 + kk) * ldw + n0 + 4 * (lane & 7)); gk[i] = gain ? gain[k0 + kk] : 1.0f; }
#pragma unroll
        for (int i = 0; i < 8; ++i) { const int kk = 8 * i + (lane >> 3); LAS float* d = scr + kk * 33 + 4 * (lane & 7);
            d[0] = v[i].x * gk[i]; d[1] = v[i].y * gk[i]; d[2] = v[i].z * gk[i]; d[3] = v[i].w * gk[i]; }
    }
    LDS_WAIT(); asm volatile("" ::: "memory");
    const int c = lane & 7;
#pragma unroll
    for (int j = 0; j < 4; ++j) { const int n = (lane >> 3) + 8 * j; const LAS float* s = scr + (8 * c) * 33 + n;
        u32x4 o; o.x = pk2(s[0 * 33], s[1 * 33]); o.y = pk2(s[2 * 33], s[3 * 33]); o.z = pk2(s[4 * 33], s[5 * 33]); o.w = pk2(s[6 * 33], s[7 * 33]);
        *(u32x4*)(WT + (size_t)(drow0 + n) * K + k0 + 8 * c) = o; }
    LDS_WAIT(); asm volatile("" ::: "memory");
}
__device__ __forceinline__ bool tr_job(int& r, const float* W, int K, int N, int ldw, const float* gain, bf16_t* WT, int drow_base, bool glu, LAS float* scr, int lane) {
    const int nb = N / 32, items = (K / 64) * nb;
    if (r >= items) { r -= items; return false; }
    const int kb = r / nb, nbk = r % nb, n0 = 32 * nbk;
    int drow0 = drow_base + n0;
    if (glu) { const int bj = n0 >> 11, j = n0 & 2047; drow0 = 256 * (j >> 7) + 128 * bj + (j & 127); }
    tr_item(W, ldw, gain, WT, K, drow0, 64 * kb, n0, scr, lane);
    return true;
}
template <int SET>
__device__ __forceinline__ void convert_weights(const Args& a, LAS unsigned char* lds, int gwi, int ngwi, int wave, int lane) {
    unsigned char* ws = a.ws;
    LAS float* scr = (LAS float*)(lds + wave * 16384);
    bf16_t* Win = (bf16_t*)(ws + WS_WIN); bf16_t* Wglu = (bf16_t*)(ws + WS_WGLU); bf16_t* Wout = (bf16_t*)(ws + WS_WOUT); bf16_t* Winb = (bf16_t*)(ws + WS_WINB);
    bf16_t* Wuq = (bf16_t*)(ws + WS_WUQ); bf16_t* Wuk = (bf16_t*)(ws + WS_WUK); bf16_t* Wuv = (bf16_t*)(ws + WS_WUV); bf16_t* Woutb = (bf16_t*)(ws + WS_WOUTB);
    constexpr int I_IN = 16 * 128, I_GLU = 32 * 128, I_OUT = 32 * 32, I_INB = 16 * 44, I_DKV = 16 * 10, I_UQ = 6 * 48, I_UK = 4 * 32, I_OUTB = 16 * 32;
    constexpr int NITEMS = SET == 0 ? I_IN : SET == 1 ? I_GLU + I_OUT : SET == 2 ? I_IN + I_GLU + I_OUT : 2 * (I_INB + I_UQ + I_OUTB) + I_DKV + 2 * I_UK;
    for (int it = gwi; it < NITEMS; it += ngwi) {
        int r = it; bool done = false;
        if (SET == 0) { done = tr_job(r, a.w_in_a, 1024, 4096, 4096, a.norm_a, Win, 0, false, scr, lane); }
        if (SET == 1) {
            if (!done) done = tr_job(r, a.w_glu, 2048, 4096, 4096, nullptr, Wglu, 0, true, scr, lane);
            if (!done) done = tr_job(r, a.w_out_a, 2048, 1024, 1024, nullptr, Wout, 0, false, scr, lane);
        }
        if (SET == 2) {
            if (!done) done = tr_job(r, a.w_in_a + (size_t)1024 * 4096, 1024, 4096, 4096, a.norm_a + 1024, Win + (size_t)4096 * 1024, 0, false, scr, lane);
            if (!done) done = tr_job(r, a.w_glu + (size_t)2048 * 4096, 2048, 4096, 4096, nullptr, Wglu + (size_t)4096 * 2048, 0, true, scr, lane);
            if (!done) done = tr_job(r, a.w_out_a + (size_t)2048 * 1024, 2048, 1024, 1024, nullptr, Wout + (size_t)1024 * 2048, 0, false, scr, lane);
        }
        if (SET == 3) {
#pragma unroll
            for (int i = 0; i < 2; ++i) {
                if (!done) done = tr_job(r, a.w_in_b + (size_t)i * 1024 * 1408, 1024, 1408, 1408, a.norm_b + i * 1024, Winb + (size_t)i * 1792 * 1024, 0, false, scr, lane);
                if (!done) done = tr_job(r, a.w_uq + (size_t)i * 384 * 1536, 384, 1536, 1536, a.norm_q + i * 384, Wuq + (size_t)i * 1536 * 384, 0, false, scr, lane);
                if (!done) done = tr_job(r, a.w_out_b + (size_t)i * 1024 * 1024, 1024, 1024, 1024, nullptr, Woutb + (size_t)i * 1024 * 1024, 0, false, scr, lane);
            }
            if (!done) done = tr_job(r, a.w_dkv, 1024, 320, 320, a.norm_kv, Winb, 1408, false, scr, lane);
            if (!done) done = tr_job(r, a.w_uk, 256, 1024, 1024, nullptr, Wuk, 0, false, scr, lane);
            if (!done) done = tr_job(r, a.w_uv, 256, 1024, 1024, nullptr, Wuv, 0, false, scr, lane);
        }
    }
}
template <int NR> __device__ __forceinline__ void xprep_rows(const Args& a, int m0, int lane) {
    bf16_t* XB = (bf16_t*)(a.ws + WS_XB); float* SSQ = (float*)(a.ws + WS_SSQ);
    f32x4 v[NR][4];
#pragma unroll
    for (int k = 0; k < NR; ++k) { const int m = m0 + k; const float* src = m < MP ? a.x_prompt + (size_t)m * D : a.x_sample + (size_t)(m - MP) * D;
#pragma unroll
        for (int j = 0; j < 4; ++j) v[k][j] = *(const f32x4*)(src + 4 * lane + 256 * j); }
#pragma unroll
    for (int k = 0; k < NR; ++k) { const int m = m0 + k; float ss = 0.f;
#pragma unroll
        for (int j = 0; j < 4; ++j) ss += (v[k][j].x * v[k][j].x + v[k][j].y * v[k][j].y) + (v[k][j].z * v[k][j].z + v[k][j].w * v[k][j].w);
        ss = wave_sum(ss);
#pragma unroll
        for (int j = 0; j < 4; ++j) { u32x2 o; o.x = pk2(v[k][j].x, v[k][j].y); o.y = pk2(v[k][j].z, v[k][j].w); *(u32x2*)(XB + (size_t)m * D + 4 * lane + 256 * j) = o; }
        if (lane < 16) SSQ[(size_t)m * 16 + lane] = lane == 0 ? ss : 0.f; }
}
__device__ __forceinline__ void prologue_phase(const Args& a, LAS unsigned char* lds, int gw, int ngw, int wave, int lane, int gtid, int gthreads) {
    unsigned char* ws = a.ws;
    bf16_t* Winb = (bf16_t*)(ws + WS_WINB);
    convert_weights<0>(a, lds, gw, ngw, wave, lane); convert_weights<1>(a, lds, gw, ngw, wave, lane); convert_weights<2>(a, lds, gw, ngw, wave, lane); convert_weights<3>(a, lds, gw, ngw, wave, lane);
    { u32x4 z = {0u, 0u, 0u, 0u};
      for (int i = gtid; i < 64 * 1024 / 8; i += gthreads) *(u32x4*)(Winb + (size_t)1728 * 1024 + (size_t)i * 8) = z;
      for (int i = gtid; i < 128 * 1024 / 8; i += gthreads) *(u32x4*)(Winb + (size_t)1792 * 1024 + (size_t)1408 * 1024 + (size_t)i * 8) = z; }
    { bf16_t* Wukb = (bf16_t*)(ws + WS_WUKB);
      for (int i = gtid; i < 256 * 1024 / 4; i += gthreads) { const f32x4 v = *(const f32x4*)(a.w_uk + (size_t)i * 4); u32x2 o; o.x = pk2(v[0], v[1]); o.y = pk2(v[2], v[3]); *(u32x2*)(Wukb + (size_t)i * 4) = o; } }
    { float* rc = (float*)(ws + WS_ROPE); float* rs = rc + 2052 * 32;
      for (int i = gtid; i < 2052 * 32; i += gthreads) { const int idx = i >> 5, f = i & 31; const int pos = idx < 2048 ? idx : 8192 + (idx - 2048);
          const float inv = (float)exp2(-(double)f * (13.287712379549449 / 32.0));
          const float ang = (float)pos * inv;
          const double rev = (double)ang * 0.15915494309189535; const float fr = (float)(rev - rint(rev));
          rc[i] = __builtin_amdgcn_cosf(fr); rs[i] = __builtin_amdgcn_sinf(fr); } }
    { f32x4* scp = (f32x4*)(ws + WS_SCP);
      for (int i = gtid; i < 2 * NG * ST; i += gthreads) { const int lg = i >> 6;
          const double dt = exp((double)a.log_dt[lg]); const double lre = (double)a.a_re[i], lim = (double)a.a_im[i];
          const double mag = exp(lre * dt); const double lbr = mag * cos(lim * dt), lbi = mag * sin(lim * dt);
          const double den = lre * lre + lim * lim, nr = lbr - 1.0;
          f32x4 o; o.x = (float)lbr; o.y = (float)lbi; o.z = (float)((nr * lre + lbi * lim) / den); o.w = (float)((lbi * lre - nr * lim) / den); scp[i] = o; } }
    for (int m0 = gw * 4; m0 < MP; m0 += ngw * 4) xprep_rows<4>(a, m0, lane);
    for (int m = MP + gw; m < M; m += ngw) xprep_rows<1>(a, m, lane);
}

constexpr int SC_ROW = 272, SC_BUF = 8 * 16 * SC_ROW;
constexpr int SC_UT = 2 * SC_BUF, SC_UP = 144;
__device__ __forceinline__ void scan_phase(const Args& a, int layer, LAS unsigned char* lds, int wg, int nwg) {
    int tid_ = threadIdx.x; asm volatile("" : "+v"(tid_));
    const int tid = tid_, lane = tid & 63, w = __builtin_amdgcn_readfirstlane(tid >> 6), gl = w >> 1, ph = w & 1, pl = lane & 31, hf = lane >> 5;
    const bf16_t* UZ = (const bf16_t*)(a.ws + WS_UZ); bf16_t* YG = (bf16_t*)(a.ws + WS_YG);
    const float* A_re = a.a_re + (size_t)layer * NG * ST; const float* A_im = a.a_im + (size_t)layer * NG * ST; const float* LDT = a.log_dt + (size_t)layer * NG;
    const float* B_re = a.b_re + (size_t)layer * NG * ST * 16; const float* B_im = a.b_im + (size_t)layer * NG * ST * 16;
    const float* C_re = a.c_re + (size_t)layer * NG * 16 * ST; const float* C_im = a.c_im + (size_t)layer * NG * 16 * ST;
    const float* DSK = a.d_skip + (size_t)layer * SSMW;
    const int ai = lane & 31, a_hf = (ai >> 2) & 1, a_t = 4 * (ai >> 3) + (ai & 3), a_kh = lane >> 5;
    const int ot = lane & 15, oq = lane >> 4;
    const int ld_t = tid >> 3, ld_ch = tid & 7;
    const LAS unsigned char* ut_a = lds + SC_UT + (a_hf * 128 + a_t) * SC_UP + (gl * 16 + 8 * a_kh) * 2;
    const LAS unsigned char* ut_o = lds + SC_UT + (ph * 128 + ot) * SC_UP + (gl * 16 + 4 * oq) * 2;
    for (int u = wg; u < 512; u += nwg) {
        const bool samp = u >= 256; const int uu = samp ? u - 256 : u;
        const int gq = uu & 31, bc = uu >> 5;
        const int g = gq * 4 + gl, p = 32 * ph + pl;
        float lr, li; bf16x8 bfr, bfi, cfr[4]; f32x4 dsk;
        {
            const f32x4 scp = *((const f32x4*)(a.ws + WS_SCP) + ((size_t)layer * NG + g) * ST + p);
            const float fre = scp.z, fim = scp.w;
            lr = scp.x; li = scp.y;
            const f32x4* br4 = (const f32x4*)(B_re + ((size_t)g * ST + p) * 16 + 8 * hf); const f32x4* bi4 = (const f32x4*)(B_im + ((size_t)g * ST + p) * 16 + 8 * hf);
            const f32x4 r0 = br4[0], r1 = br4[1], i0 = bi4[0], i1 = bi4[1];
            float re[8] = {r0.x, r0.y, r0.z, r0.w, r1.x, r1.y, r1.z, r1.w}, im[8] = {i0.x, i0.y, i0.z, i0.w, i1.x, i1.y, i1.z, i1.w};
            unsigned pr[4], pi[4];
#pragma unroll
            for (int j = 0; j < 4; ++j) { pr[j] = pk2(fre * re[2 * j] - fim * im[2 * j], fre * re[2 * j + 1] - fim * im[2 * j + 1]); pi[j] = pk2(fre * im[2 * j] + fim * re[2 * j], fre * im[2 * j + 1] + fim * re[2 * j + 1]); }
            u32x4 t; t.x = pr[0]; t.y = pr[1]; t.z = pr[2]; t.w = pr[3]; bfr = __builtin_bit_cast(bf16x8, t); t.x = pi[0]; t.y = pi[1]; t.z = pi[2]; t.w = pi[3]; bfi = __builtin_bit_cast(bf16x8, t);
#pragma unroll
            for (int s = 0; s < 4; ++s) { const f32x4 cr = *(const f32x4*)(C_re + ((size_t)g * 16 + ot) * ST + 16 * s + 4 * oq); const f32x4 ci = *(const f32x4*)(C_im + ((size_t)g * 16 + ot) * ST + 16 * s + 4 * oq);
                u32x4 c4; c4.x = pk2(cr.x, -ci.x); c4.y = pk2(cr.y, -ci.y); c4.z = pk2(cr.z, -ci.z); c4.w = pk2(cr.w, -ci.w); cfr[s] = __builtin_bit_cast(bf16x8, c4); }
            dsk = *(const f32x4*)(DSK + g * 16 + 4 * oq);
            asm volatile("" :: "v"(dsk));
        }
        const int nit = samp ? 8 : 1, L = samp ? 4 : SEQ, nchunk = samp ? 1 : SEQ / 128;
        u32x4 pre[4]; float xr_n = 0.f, xi_n = 0.f;
        for (int it = 0; it < nit; ++it) {
            const int bp = samp ? bc * 8 + it : bc;
            const int b_scan = 2 * bp + hf, b_o = 2 * bp + ph;
            const size_t rb0 = samp ? (size_t)MP + (size_t)(2 * bp) * 4 : (size_t)(2 * bp) * SEQ;
            const size_t rb_o = rb0 + (size_t)ph * L;
            float xr = 0.f, xi = 0.f;
            const bf16_t* gsrc = UZ + gq * 64 + ld_ch * 8;
#define SC_LOADB(rb, c0) do { if (!samp) { _Pragma("unroll") for (int i_ = 0; i_ < 4; ++i_) pre[i_] = *(const u32x4*)(gsrc + ((rb) + (size_t)(i_ >> 1) * L + (c0) + ld_t + 64 * (i_ & 1)) * 4096); } \
            else { _Pragma("unroll") for (int i_ = 0; i_ < 4; ++i_) { const int t_ = (c0) + ld_t + 64 * (i_ & 1); pre[i_] = (u32x4){0u, 0u, 0u, 0u}; \
                if (t_ < L) pre[i_] = *(const u32x4*)(gsrc + ((rb) + (size_t)(i_ >> 1) * L + t_) * 4096); } } } while (0)
#define SC_LOAD(c0) SC_LOADB(rb0, c0)
            if (samp && it > 0) { xr = xr_n; xi = xi_n; }
            else { if (samp) { const size_t so = (((size_t)layer * 128 + b_scan) * NG + g) * ST + p; xr = a.state_re[so]; xi = a.state_im[so]; }
                   SC_LOAD(0); }
            const int nblk = samp ? 1 : SEQ / 16;
            LAS unsigned* wp0 = (LAS unsigned*)(lds + ((gl * 2 + hf) * 16) * SC_ROW + p * 4);
            const float nli = -li;
            const LAS unsigned char* rp0 = lds + ((gl * 2 + ph) * 16 + ot) * SC_ROW + oq * 16;
            u32x2 us_prev = {0u, 0u};
#define SC_OUT(m, check) do { const LAS unsigned char* rp_ = rp0 + ((m) & 1) * SC_BUF; f32x4 yv_ = {0.f, 0.f, 0.f, 0.f}; \
                _Pragma("unroll") for (int s_ = 0; s_ < 4; ++s_) { const bf16x8 xb_ = *(const LAS bf16x8*)(rp_ + s_ * 64); yv_ = __builtin_amdgcn_mfma_f32_16x16x32_bf16(cfr[s_], xb_, yv_, 0, 0, 0); } \
                if (!(check) || ((m) * 16 + ot < L)) { \
                    const float y0_ = gelu_tanh(yv_[0] + dsk.x * bflo(us_prev.x)), y1_ = gelu_tanh(yv_[1] + dsk.y * bfhi(us_prev.x)), y2_ = gelu_tanh(yv_[2] + dsk.z * bflo(us_prev.y)), y3_ = gelu_tanh(yv_[3] + dsk.w * bfhi(us_prev.y)); \
                    u32x2 o_; o_.x = pk2(y0_, y1_); o_.y = pk2(y2_, y3_); *(u32x2*)(YG + (rb_o + (m) * 16 + ot) * SSMW + g * 16 + 4 * oq) = o_; } } while (0)
            {
#pragma unroll
                for (int i_ = 0; i_ < 4; ++i_) *(LAS u32x4*)(lds + SC_UT + ((i_ >> 1) * 128 + ld_t + 64 * (i_ & 1)) * SC_UP + ld_ch * 16) = pre[i_];
                WG_BAR();
                if (8 < nblk) SC_LOAD(128);
                if (samp && it + 1 < nit) {
                    const int bpn = bc * 8 + it + 1; const size_t rbn = (size_t)MP + (size_t)(2 * bpn) * 4;
                    SC_LOADB(rbn, 0);
                    const size_t son = (((size_t)layer * 128 + 2 * bpn + hf) * NG + g) * ST + p; xr_n = a.state_re[son]; xi_n = a.state_im[son]; }
                const bf16x8 acur = *(const LAS bf16x8*)(ut_a);
                us_prev = *(const LAS u32x2*)(ut_o);
                f32x16 bur, bui;
#pragma unroll
                for (int r = 0; r < 16; ++r) { bur[r] = 0.f; bui[r] = 0.f; }
                bur = __builtin_amdgcn_mfma_f32_32x32x16_bf16(acur, bfr, bur, 0, 0, 0);
                bui = __builtin_amdgcn_mfma_f32_32x32x16_bf16(acur, bfi, bui, 0, 0, 0);
                const int nst = L < 16 ? L : 16;
#pragma unroll
                for (int r = 0; r < 16; ++r) {
                    if (r < nst) {
                        const float t1 = fmaf(lr, xr, bur[r]), t2 = fmaf(lr, xi, bui[r]);
                        const float nxr = fmaf(-li, xi, t1), nxi = fmaf(li, xr, t2);
                        xr = nxr; xi = nxi;
                        wp0[r * (SC_ROW / 4)] = pk2(xr, xi);
                    }
                }
                WG_BAR();
            }
            for (int n = 1; n < nblk; ++n) {
                if ((n & 7) == 0) {
#pragma unroll
                    for (int i_ = 0; i_ < 4; ++i_) *(LAS u32x4*)(lds + SC_UT + ((i_ >> 1) * 128 + ld_t + 64 * (i_ & 1)) * SC_UP + ld_ch * 16) = pre[i_];
                    WG_BAR();
                    if (n + 8 < nblk) SC_LOAD((n + 8) * 16);
                }
                const int blk = n & 7;
                const bf16x8 acur = *(const LAS bf16x8*)(ut_a + blk * 16 * SC_UP);
                const u32x2 us_cur = *(const LAS u32x2*)(ut_o + blk * 16 * SC_UP);
                f32x16 bur, bui;
#pragma unroll
                for (int r = 0; r < 16; ++r) { bur[r] = 0.f; bui[r] = 0.f; }
                bur = __builtin_amdgcn_mfma_f32_32x32x16_bf16(acur, bfr, bur, 0, 0, 0);
                bui = __builtin_amdgcn_mfma_f32_32x32x16_bf16(acur, bfi, bui, 0, 0, 0);
                const LAS unsigned char* rpo = rp0 + ((n - 1) & 1) * SC_BUF; f32x4 yv = {0.f, 0.f, 0.f, 0.f};
#pragma unroll
                for (int s_ = 0; s_ < 4; ++s_) { const bf16x8 xb_ = *(const LAS bf16x8*)(rpo + s_ * 64); yv = __builtin_amdgcn_mfma_f32_16x16x32_bf16(cfr[s_], xb_, yv, 0, 0, 0); }
                LAS unsigned* wp = wp0 + (n & 1) * (SC_BUF / 4);
                float yo[4];
#pragma unroll
                for (int r = 0; r < 16; ++r) {
                    const float t1 = fmaf(lr, xr, bur[r]), t2 = fmaf(lr, xi, bui[r]);
                    const float nxr = fmaf(nli, xi, t1), nxi = fmaf(li, xr, t2);
                    xr = nxr; xi = nxi;
                    wp[r * (SC_ROW / 4)] = pk2(xr, xi);
                    if (r == 3)  yo[0] = gelu_tanh(yv[0] + dsk.x * bflo(us_prev.x));
                    if (r == 6)  yo[1] = gelu_tanh(yv[1] + dsk.y * bfhi(us_prev.x));
                    if (r == 9)  yo[2] = gelu_tanh(yv[2] + dsk.z * bflo(us_prev.y));
                    if (r == 12) yo[3] = gelu_tanh(yv[3] + dsk.w * bfhi(us_prev.y));
                }
                { u32x2 o_; o_.x = pk2(yo[0], yo[1]); o_.y = pk2(yo[2], yo[3]); *(u32x2*)(YG + (rb_o + (n - 1) * 16 + ot) * SSMW + g * 16 + 4 * oq) = o_; }
                WG_BAR();
                us_prev = us_cur;
            }
            SC_OUT(nblk - 1, true);
#undef SC_OUT
#undef SC_LOAD
#undef SC_LOADB
            { const size_t so = samp ? (((size_t)layer * 128 + b_scan) * NG + g) * ST + p : (((size_t)layer * 16 + b_scan) * NG + g) * ST + p;
              float* ore = a.out + (samp ? O_HSR : O_HPR); float* oim = a.out + (samp ? O_HSI : O_HPI);
              ore[so] = xr; oim[so] = xi; }
        }
        WG_BAR();
    }
}

template <int NR> __device__ __forceinline__ void t1_rows(const Args& a, int j, int m0, int lane) {
    const bf16_t* C1 = (const bf16_t*)(a.ws + WS_C1); bf16_t* CQN = (bf16_t*)(a.ws + WS_CQN); bf16_t* LATB = (bf16_t*)(a.ws + WS_LATB); bf16_t* KRB = (bf16_t*)(a.ws + WS_KRB);
    const float* rc = (const float*)(a.ws + WS_ROPE); const float* rs = rc + 2052 * 32;
    {
        u32x2 rawl[NR]; unsigned short k1[NR], k2[NR];
#pragma unroll
        for (int k = 0; k < NR; ++k) { const bf16_t* c1 = C1 + (size_t)(m0 + k) * LDC1;
            if (j == 0) { rawl[k] = *(const u32x2*)(c1 + 1408 + 4 * lane); k1[k] = c1[1408 + 256 + (lane & 31)]; k2[k] = c1[1408 + 256 + 32 + (lane & 31)]; } }
#pragma unroll
        for (int k = 0; k < NR; ++k) { const int m = m0 + k;
            if (j == 0) {
                const float l0 = bflo(rawl[k].x), l1 = bfhi(rawl[k].x), l2 = bflo(rawl[k].y), l3 = bfhi(rawl[k].y);
                const float s2 = wave_sum((l0 * l0 + l1 * l1) + (l2 * l2 + l3 * l3));
                const float rl = __builtin_amdgcn_rsqf(s2 * (1.0f / KVL) + EPS);
                const f32x4 gl4 = *(const f32x4*)(a.norm_latent + 4 * lane);
                f32x4 o; o.x = l0 * rl * gl4.x; o.y = l1 * rl * gl4.y; o.z = l2 * rl * gl4.z; o.w = l3 * rl * gl4.w;
                float* olat = m < MP ? a.out + O_LATP + (size_t)m * KVL : a.out + O_LATS + (size_t)(m - MP) * KVL;
                *(f32x4*)(olat + 4 * lane) = o;
                u32x2 ob; ob.x = pk2(o.x, o.y); ob.y = pk2(o.z, o.w); *(u32x2*)(LATB + (size_t)m * KVL + 4 * lane) = ob;
                if (lane < 32) {
                    const float x1 = bf1(k1[k]), x2 = bf1(k2[k]);
                    const int idx = m < MP ? (m & (SEQ - 1)) : 2048 + ((m - MP) & 3);
                    const float c = rc[idx * 32 + lane], s = rs[idx * 32 + lane];
                    const float o1 = x1 * c - x2 * s, o2 = x1 * s + x2 * c;
                    float* okr = m < MP ? a.out + O_KRP + (size_t)m * ROPE : a.out + O_KRS + (size_t)(m - MP) * ROPE;
                    okr[lane] = o1; okr[32 + lane] = o2;
                    KRB[(size_t)m * ROPE + lane] = f2bf(o1); KRB[(size_t)m * ROPE + 32 + lane] = f2bf(o2);
                }
            }
        }
    }
}
__device__ __forceinline__ void t1_phase(const Args& a, int j, int gw, int ngw, int lane) {
    for (int m0 = gw * 4; m0 < MP; m0 += ngw * 4) t1_rows<4>(a, j, m0, lane);
    for (int m = MP + gw; m < M; m += ngw) t1_rows<1>(a, j, m, lane);
}
template <int NR> __device__ __forceinline__ void final_rows(const Args& a, const f32x4 (&g)[4], int m0, int lane) {
    const bf16_t* XB = (const bf16_t*)(a.ws + WS_XB); const float* SSQ = (const float*)(a.ws + WS_SSQ);
    u32x4 v[NR][2]; float sq[NR];
#pragma unroll
    for (int k = 0; k < NR; ++k) { sq[k] = SSQ[(size_t)(m0 + k) * 16 + (lane & 15)];
#pragma unroll
        for (int j = 0; j < 2; ++j) v[k][j] = *(const u32x4*)(XB + (size_t)(m0 + k) * D + 8 * lane + 512 * j); }
#pragma unroll
    for (int k = 0; k < NR; ++k) { const int m = m0 + k;
        const float r = __builtin_amdgcn_rsqf(wave_sum(lane < 16 ? sq[k] : 0.f) * (1.0f / D) + EPS);
        float* o = m < MP ? a.out + O_YP + (size_t)m * D : a.out + O_YS + (size_t)(m - MP) * D;
#pragma unroll
        for (int j = 0; j < 2; ++j) { const u32x4 x = v[k][j]; f32x4 y0, y1;
            y0.x = bflo(x.x) * r * g[2 * j].x; y0.y = bfhi(x.x) * r * g[2 * j].y; y0.z = bflo(x.y) * r * g[2 * j].z; y0.w = bfhi(x.y) * r * g[2 * j].w;
            y1.x = bflo(x.z) * r * g[2 * j + 1].x; y1.y = bfhi(x.z) * r * g[2 * j + 1].y; y1.z = bflo(x.w) * r * g[2 * j + 1].z; y1.w = bfhi(x.w) * r * g[2 * j + 1].w;
            *(f32x4*)(o + 8 * lane + 512 * j) = y0; *(f32x4*)(o + 8 * lane + 512 * j + 4) = y1; } }
}
__device__ __forceinline__ void final_phase(const Args& a, int gw, int ngw, int lane) {
    f32x4 g[4];
#pragma unroll
    for (int j = 0; j < 4; ++j) g[j] = *(const f32x4*)(a.norm_f + 8 * lane + 512 * (j >> 1) + 4 * (j & 1));
    for (int m0 = gw * 4; m0 < MP; m0 += ngw * 4) final_rows<4>(a, g, m0, lane);
    for (int m = MP + gw; m < M; m += ngw) final_rows<1>(a, g, m, lane);
}

template <int OFF> __device__ __forceinline__ void ds_read128(bf16x8& d, unsigned addr) { asm volatile("ds_read_b128 %0, %1 offset:%2" : "=v"(d) : "v"(addr), "n"(OFF)); }
template <int N> __device__ __forceinline__ void lgkm_wait_dep(bf16x8& x) { asm volatile("s_waitcnt lgkmcnt(%1)" : "+v"(x) : "n"(N)); }
constexpr int AT_KP = 400, AT_VP = 144, AT_KB = 64 * AT_KP, AT_VB = 128 * AT_VP, AT_STAGE = AT_KB + AT_VB;
__device__ __forceinline__ int pi32(int i) { return (i & 19) | ((i & 4) << 1) | ((i & 8) >> 1); }
constexpr int AT_RING = 6;
template <int I> __device__ __forceinline__ void at_qk_steps(bf16x8 (&ring)[AT_RING], unsigned kaddr, const bf16x8 (&qf)[12], f32x16 (&sacc)[2]) {
    if constexpr (I < 24) {
        lgkm_wait_dep<(23 - I < AT_RING - 1 ? 23 - I : AT_RING - 1)>(ring[I % AT_RING]);
        sacc[I / 12] = __builtin_amdgcn_mfma_f32_32x32x16_bf16(ring[I % AT_RING], qf[I % 12], sacc[I / 12], 0, 0, 0);
        if constexpr (I + AT_RING < 24) ds_read128<((I + AT_RING) / 12) * 32 * AT_KP + ((I + AT_RING) % 12) * 32>(ring[I % AT_RING], kaddr);
        at_qk_steps<I + 1>(ring, kaddr, qf, sacc);
    }
}
template <int I> __device__ __forceinline__ void at_pv_steps(bf16x8 (&ring)[AT_RING], unsigned vaddr, const bf16x8 (&pf)[4], f32x16 (&oacc)[4]) {
    if constexpr (I < 16) {
        lgkm_wait_dep<(15 - I < AT_RING - 1 ? 15 - I : AT_RING - 1)>(ring[I % AT_RING]);
        oacc[I / 4] = __builtin_amdgcn_mfma_f32_32x32x16_bf16(ring[I % AT_RING], pf[I % 4], oacc[I / 4], 0, 0, 0);
        if constexpr (I + AT_RING < 16) ds_read128<((I + AT_RING) / 4) * 32 * AT_VP + ((I + AT_RING) % 4) * 32>(ring[I % AT_RING], vaddr);
        at_pv_steps<I + 1>(ring, vaddr, pf, oacc);
    }
}
__device__ __forceinline__ void attn_prompt_block(const Args& a, LAS unsigned char* lds, int b, int h, int qb) {
    int tid_ = threadIdx.x; asm volatile("" : "+v"(tid_));
    const int tid = tid_, lane = tid & 63, w = __builtin_amdgcn_readfirstlane(tid >> 6), qi = lane & 31, kh = lane >> 5;
    const bf16_t* Q = (const bf16_t*)(a.ws + WS_Q); const bf16_t* KN = (const bf16_t*)(a.ws + WS_KN); const bf16_t* KRB = (const bf16_t*)(a.ws + WS_KRB);
    const bf16_t* VT = (const bf16_t*)(a.ws + WS_VT); const bf16_t* C1 = (const bf16_t*)(a.ws + WS_C1); bf16_t* OG = (bf16_t*)(a.ws + WS_OG);
    const float* rc = (const float*)(a.ws + WS_ROPE); const float* rs = rc + 2052 * 32;
    const int q0 = qb * 256 + 32 * w, qpos = q0 + qi; const size_t mrow = (size_t)b * SEQ + qpos;
    const int half = w >> 2, htid = tid & 255;
    const bf16_t* gk = KN + ((size_t)(b * 8 + h) * SEQ + (htid >> 4)) * 128 + (htid & 15) * 8;
    const bf16_t* gr = KRB + ((size_t)b * SEQ + (htid >> 3)) * ROPE + (htid & 7) * 8;
    const bf16_t* gv = VT + ((size_t)(b * 8 + h) * 32 * 128 + (htid >> 3)) * 64 + (htid & 7) * 8;
    const int lk = (htid >> 4) * AT_KP + (htid & 15) * 16, lr_ = (htid >> 3) * AT_KP + 256 + (htid & 7) * 16, lv = AT_KB + (htid >> 3) * AT_VP + (htid & 7) * 16;
    u32x4 rk[4], rr[2], rv[4];
#define AT_LOAD(k0) do { _Pragma("unroll") for (int i_ = 0; i_ < 4; ++i_) rk[i_] = *(const u32x4*)(gk + ((size_t)(k0) + 16 * i_) * 128); \
        _Pragma("unroll") for (int i_ = 0; i_ < 2; ++i_) rr[i_] = *(const u32x4*)(gr + ((size_t)(k0) + 32 * i_) * ROPE); \
        _Pragma("unroll") for (int i_ = 0; i_ < 4; ++i_) rv[i_] = *(const u32x4*)(gv + (size_t)(k0) * 128 + (size_t)(32 * i_) * 64); } while (0)
#define AT_STORE(st) do { LAS unsigned char* sb_ = lds + (st) * AT_STAGE; \
        _Pragma("unroll") for (int i_ = 0; i_ < 4; ++i_) *(LAS u32x4*)(sb_ + lk + 16 * i_ * AT_KP) = rk[i_]; \
        _Pragma("unroll") for (int i_ = 0; i_ < 2; ++i_) *(LAS u32x4*)(sb_ + lr_ + 32 * i_ * AT_KP) = rr[i_]; \
        _Pragma("unroll") for (int i_ = 0; i_ < 4; ++i_) *(LAS u32x4*)(sb_ + lv + 32 * i_ * AT_VP) = rv[i_]; } while (0)
    AT_LOAD(half * 64);
    bf16x8 qf[12];
#pragma unroll
    for (int s = 0; s < 12; ++s) qf[s] = *(const bf16x8*)(Q + mrow * 1536 + h * 192 + 16 * s + 8 * kh);
#pragma unroll
    for (int pr = 0; pr < 2; ++pr) {
        const int jj0 = 16 * pr + 8 * kh;
        const u32x4 x1r = __builtin_bit_cast(u32x4, qf[8 + pr]), x2r = __builtin_bit_cast(u32x4, qf[10 + pr]);
        const f32x4 c0 = *(const f32x4*)(rc + qpos * 32 + jj0), c1 = *(const f32x4*)(rc + qpos * 32 + jj0 + 4), s0 = *(const f32x4*)(rs + qpos * 32 + jj0), s1 = *(const f32x4*)(rs + qpos * 32 + jj0 + 4);
        const float cc[8] = {c0.x, c0.y, c0.z, c0.w, c1.x, c1.y, c1.z, c1.w}, sn[8] = {s0.x, s0.y, s0.z, s0.w, s1.x, s1.y, s1.z, s1.w};
        const float x1[8] = {bflo(x1r.x), bfhi(x1r.x), bflo(x1r.y), bfhi(x1r.y), bflo(x1r.z), bfhi(x1r.z), bflo(x1r.w), bfhi(x1r.w)};
        const float x2[8] = {bflo(x2r.x), bfhi(x2r.x), bflo(x2r.y), bfhi(x2r.y), bflo(x2r.z), bfhi(x2r.z), bflo(x2r.w), bfhi(x2r.w)};
        float o1[8], o2[8];
#pragma unroll
        for (int e = 0; e < 8; ++e) { o1[e] = x1[e] * cc[e] - x2[e] * sn[e]; o2[e] = x1[e] * sn[e] + x2[e] * cc[e]; }
        u32x4 t; t.x = pk2(o1[0], o1[1]); t.y = pk2(o1[2], o1[3]); t.z = pk2(o1[4], o1[5]); t.w = pk2(o1[6], o1[7]); qf[8 + pr] = __builtin_bit_cast(bf16x8, t);
        t.x = pk2(o2[0], o2[1]); t.y = pk2(o2[2], o2[3]); t.z = pk2(o2[4], o2[5]); t.w = pk2(o2[6], o2[7]); qf[10 + pr] = __builtin_bit_cast(bf16x8, t);
    }
    f32x16 oacc[4];
#pragma unroll
    for (int d = 0; d < 4; ++d)
#pragma unroll
        for (int r = 0; r < 16; ++r) oacc[d][r] = 0.f;
    float m_run = -1e30f, lsum = 0.f;
    const int nt = 4 * (qb + 1);
    if (half == 0) { AT_STORE(0); }
    LDS_WAIT(); __syncthreads();
#pragma unroll
    for (int s = 0; s < 12; ++s) asm volatile("" :: "v"(qf[s]));
    if (half == 0) AT_LOAD(128);
    const int krow = pi32(qi) * AT_KP + kh * 16;
    const int vrow = AT_KB + qi * AT_VP + kh * 16;
    for (int jt = 0; jt < nt; ++jt) {
        const int k0 = jt * 64;
        const LAS unsigned char* sb = lds + (jt & 1) * AT_STAGE;
        const bool active = !(jt >= nt - 4 && 64 * (jt - (nt - 4)) > 32 * w + 31);
        if (active) {
        f32x16 sacc[2];
#pragma unroll
        for (int kb = 0; kb < 2; ++kb)
#pragma unroll
            for (int r = 0; r < 16; ++r) sacc[kb][r] = 0.f;
        bf16x8 ring[AT_RING];
        { const unsigned kaddr = (unsigned)(size_t)(sb + krow);
          ds_read128<0>(ring[0], kaddr); ds_read128<32>(ring[1], kaddr); ds_read128<64>(ring[2], kaddr); ds_read128<96>(ring[3], kaddr); ds_read128<128>(ring[4], kaddr); ds_read128<160>(ring[5], kaddr);
          at_qk_steps<0>(ring, kaddr, qf, sacc); }
        if (jt >= nt - 4) {
#pragma unroll
            for (int kb = 0; kb < 2; ++kb)
#pragma unroll
                for (int r = 0; r < 16; ++r) { const int key = k0 + 32 * kb + (r & 3) + 4 * ((r >> 2) & 1) + 8 * kh + 16 * (r >> 3); if (key > qpos) sacc[kb][r] = -INFINITY; }
        }
        float mx = sacc[0][0];
#pragma unroll
        for (int kb = 0; kb < 2; ++kb)
#pragma unroll
            for (int r = 0; r < 16; ++r) mx = fmaxf(mx, sacc[kb][r]);
        mx = fmaxf(mx, __shfl_xor(mx, 32));
        const float m_tile = mx * SM_SCALE_LOG2;
        if (__any(m_tile > m_run + 8.0f)) {
            const float m_new = fmaxf(m_run, m_tile);
            const float alpha = fast_exp2(m_run - m_new); m_run = m_new;
            lsum *= alpha;
#pragma unroll
            for (int d = 0; d < 4; ++d)
#pragma unroll
                for (int r = 0; r < 16; ++r) oacc[d][r] *= alpha;
        }
        float ps = 0.f;
#pragma unroll
        for (int kb = 0; kb < 2; ++kb)
#pragma unroll
            for (int r = 0; r < 16; ++r) { const float pv = fast_exp2(fmaf(sacc[kb][r], SM_SCALE_LOG2, -m_run)); sacc[kb][r] = pv; ps += pv; }
        lsum += ps;
        bf16x8 pf[4];
#pragma unroll
        for (int ks = 0; ks < 4; ++ks) { const int kb = ks >> 1, rb = 8 * (ks & 1); u32x4 t; t.x = pk2(sacc[kb][rb], sacc[kb][rb + 1]); t.y = pk2(sacc[kb][rb + 2], sacc[kb][rb + 3]); t.z = pk2(sacc[kb][rb + 4], sacc[kb][rb + 5]); t.w = pk2(sacc[kb][rb + 6], sacc[kb][rb + 7]); pf[ks] = __builtin_bit_cast(bf16x8, t); }
        { const unsigned vaddr = (unsigned)(size_t)(sb + vrow);
          ds_read128<0>(ring[0], vaddr); ds_read128<32>(ring[1], vaddr); ds_read128<64>(ring[2], vaddr); ds_read128<96>(ring[3], vaddr); ds_read128<32 * AT_VP>(ring[4], vaddr); ds_read128<32 * AT_VP + 32>(ring[5], vaddr);
          at_pv_steps<0>(ring, vaddr, pf, oacc); }
        }
        if (((jt + 1) & 1) == half && jt + 1 < nt) { AT_STORE((jt + 1) & 1); if (jt + 3 < nt) AT_LOAD(k0 + 192); }
        WG_BAR();
    }
#undef AT_LOAD
#undef AT_STORE
    const float ltot = lsum + __shfl_xor(lsum, 32); const float inv = 1.0f / ltot;
    u32x4 gall[8];
#pragma unroll
    for (int i = 0; i < 8; ++i) gall[i] = *(const u32x4*)(C1 + mrow * LDC1 + QL + h * 128 + 32 * (i >> 1) + 16 * (i & 1) + 8 * kh);
#pragma unroll
    for (int d = 0; d < 4; ++d)
#pragma unroll
        for (int p = 0; p < 2; ++p) {
            float lo[4], hi[4];
#pragma unroll
            for (int e = 0; e < 4; ++e) { const float qa = oacc[d][8 * p + e], qb_ = oacc[d][8 * p + 4 + e];
                const float recv = __shfl_xor(kh ? qa : qb_, 32);
                lo[e] = kh ? recv : qa; hi[e] = kh ? qb_ : recv; }
            const u32x4 gr = gall[d * 2 + p];
            u32x4 o;
            o.x = pk2(lo[0] * inv * siluf_(bflo(gr.x)), lo[1] * inv * siluf_(bfhi(gr.x))); o.y = pk2(lo[2] * inv * siluf_(bflo(gr.y)), lo[3] * inv * siluf_(bfhi(gr.y)));
            o.z = pk2(hi[0] * inv * siluf_(bflo(gr.z)), hi[1] * inv * siluf_(bfhi(gr.z))); o.w = pk2(hi[2] * inv * siluf_(bflo(gr.w)), hi[3] * inv * siluf_(bfhi(gr.w)));
            *(u32x4*)(OG + mrow * D + h * 128 + 32 * d + 16 * p + 8 * kh) = o;
        }
}

template <int OFF> __device__ __forceinline__ void ds_read_tr64(u32x2& d, unsigned addr) { asm volatile("ds_read_b64_tr_b16 %0, %1 offset:%2" : "=v"(d) : "v"(addr), "n"(OFF)); }
template <int N> __device__ __forceinline__ void lgkm_wait_dep3(bf16x8& x, bf16x8& y, bf16x8& z) { asm volatile("s_waitcnt lgkmcnt(%3)" : "+v"(x), "+v"(y), "+v"(z) : "n"(N)); }
template <int N> __device__ __forceinline__ void lgkm_wait_dep3t(bf16x8& x, u32x2& y, u32x2& z) { asm volatile("s_waitcnt lgkmcnt(%3)" : "+v"(x), "+v"(y), "+v"(z) : "n"(N)); }
constexpr int SA_KP = 656, SA_KN = 0, SA_QS = 128 * SA_KP  , SA_PP = 272, SA_PT = SA_QS + 32 * SA_KP  , SA_MX = SA_PT + 32 * SA_PP  , SA_PS = SA_MX + 1024  ;
template <int I> __device__ __forceinline__ void sa_qk_steps(bf16x8 (&kr)[3], bf16x8 (&qa)[3], bf16x8 (&qb)[3], unsigned kaddr, unsigned qaddr, f32x4& s0, f32x4& s1) {
    if constexpr (I < 10) {
        lgkm_wait_dep3<(9 - I < 2 ? 3 * (9 - I) : 6)>(kr[I % 3], qa[I % 3], qb[I % 3]);
        s0 = __builtin_amdgcn_mfma_f32_16x16x32_bf16(kr[I % 3], qa[I % 3], s0, 0, 0, 0);
        s1 = __builtin_amdgcn_mfma_f32_16x16x32_bf16(kr[I % 3], qb[I % 3], s1, 0, 0, 0);
        if constexpr (I + 3 < 10) { ds_read128<(I + 3) * 64>(kr[I % 3], kaddr); ds_read128<(I + 3) * 64>(qa[I % 3], qaddr); ds_read128<(I + 3) * 64 + 16 * SA_KP>(qb[I % 3], qaddr); }
        sa_qk_steps<I + 1>(kr, qa, qb, kaddr, qaddr, s0, s1);
    }
}
template <int I> __device__ __forceinline__ void sa_pv_steps(bf16x8 (&pf)[3], u32x2 (&ta)[3], u32x2 (&tb)[3], unsigned paddr, unsigned va0, unsigned va1, f32x16& oacc) {
    if constexpr (I < 8) {
        lgkm_wait_dep3t<(7 - I < 2 ? 3 * (7 - I) : 6)>(pf[I % 3], ta[I % 3], tb[I % 3]);
        u32x4 v; v.x = ta[I % 3].x; v.y = ta[I % 3].y; v.z = tb[I % 3].x; v.w = tb[I % 3].y;
        oacc = __builtin_amdgcn_mfma_f32_32x32x16_bf16(__builtin_bit_cast(bf16x8, v), pf[I % 3], oacc, 0, 0, 0);
        if constexpr (I + 3 < 8) { ds_read128<(I + 3) * 32>(pf[I % 3], paddr);
            ds_read_tr64<((I + 3) & 3) * 16 * SA_KP>(ta[I % 3], (I + 3) < 4 ? va0 : va1); ds_read_tr64<((I + 3) & 3) * 16 * SA_KP + 4 * SA_KP>(tb[I % 3], (I + 3) < 4 ? va0 : va1); }
        sa_pv_steps<I + 1>(pf, ta, tb, paddr, va0, va1, oacc);
    }
}
__device__ __forceinline__ void attn_sample_unit(const Args& a, LAS unsigned char* lds, int s, int sp) {
    int tid_ = threadIdx.x; asm volatile("" : "+v"(tid_));
    const int tid = tid_, lane = tid & 63, w = __builtin_amdgcn_readfirstlane(tid >> 6), qi = lane & 31, kh = lane >> 5;
    const bf16_t* Q = (const bf16_t*)(a.ws + WS_Q); const bf16_t* WUKB = (const bf16_t*)(a.ws + WS_WUKB); const bf16_t* LATB = (const bf16_t*)(a.ws + WS_LATB); const bf16_t* KRB = (const bf16_t*)(a.ws + WS_KRB);
    const float* rc = (const float*)(a.ws + WS_ROPE); const float* rs = rc + 2052 * 32;
    float* PART = (float*)(a.ws + WS_PART) + (size_t)(s * 2 + sp) * PART_STRIDE;
    const size_t row0 = (size_t)MP + (size_t)s * 4;
    f32x4 rl[16], rr[4];
    const int ptv = a.page_table[s * NPAGES + sp * 32 + (lane & 31)];
#define SA_LOAD(jt) do { const int phys_ = __builtin_amdgcn_readlane(ptv, (jt)); const size_t kb_ = (size_t)phys_ * PAGE; \
        _Pragma("unroll") for (int i_ = 0; i_ < 4; ++i_) rr[i_] = __builtin_nontemporal_load((const f32x4*)(a.cache_krope + kb_ * ROPE) + tid + 512 * i_); \
        _Pragma("unroll") for (int i_ = 0; i_ < 16; ++i_) rl[i_] = __builtin_nontemporal_load((const f32x4*)(a.cache_latent + kb_ * KVL) + tid + 512 * i_); } while (0)
    SA_LOAD(0);
    {
        const int h = w;
        bf16x8 bq[8];
#pragma unroll
        for (int st = 0; st < 8; ++st) bq[st] = *(const bf16x8*)(Q + (row0 + (qi & 3)) * 1536 + h * 192 + 16 * st + 8 * kh);
#pragma unroll
        for (int st = 0; st < 8; ++st) { if (qi >= 4) bq[st] = (bf16x8){0, 0, 0, 0, 0, 0, 0, 0}; }
        bf16x8 wf[3][8];
#pragma unroll
        for (int pb = 0; pb < 3; ++pb)
#pragma unroll
            for (int st = 0; st < 8; ++st) wf[pb][st] = *(const bf16x8*)(WUKB + (size_t)(32 * pb + qi) * 1024 + h * 128 + 16 * st + 8 * kh);
#pragma unroll
        for (int cb = 0; cb < 8; ++cb) {
            f32x16 acc;
#pragma unroll
            for (int r = 0; r < 16; ++r) acc[r] = 0.f;
#pragma unroll
            for (int st = 0; st < 8; ++st) acc = __builtin_amdgcn_mfma_f32_32x32x16_bf16(wf[cb % 3][st], bq[st], acc, 0, 0, 0);
            if (cb + 3 < 8) {
#pragma unroll
                for (int st = 0; st < 8; ++st) wf[cb % 3][st] = *(const bf16x8*)(WUKB + (size_t)(32 * (cb + 3) + qi) * 1024 + h * 128 + 16 * st + 8 * kh);
            }
            if (qi < 4) {
#pragma unroll
                for (int rq = 0; rq < 4; ++rq) { const int c0 = 32 * cb + 8 * rq + 4 * kh; u32x2 o; o.x = pk2(acc[4 * rq] * SM_SCALE_LOG2, acc[4 * rq + 1] * SM_SCALE_LOG2); o.y = pk2(acc[4 * rq + 2] * SM_SCALE_LOG2, acc[4 * rq + 3] * SM_SCALE_LOG2);
                    *(LAS u32x2*)(lds + SA_QS + (qi * 8 + h) * SA_KP + c0 * 2) = o; }
            }
        }
        { const int t = lane >> 4, j0 = 2 * (lane & 15); const bf16_t* qr = Q + (row0 + t) * 1536 + h * 192 + 128;
          const unsigned x1r = *(const unsigned*)(qr + j0), x2r = *(const unsigned*)(qr + 32 + j0);
          const int idx = 2048 + t; const float c0 = rc[idx * 32 + j0], c1 = rc[idx * 32 + j0 + 1], s0 = rs[idx * 32 + j0], s1 = rs[idx * 32 + j0 + 1];
          const float a0 = bflo(x1r), a1 = bfhi(x1r), b0 = bflo(x2r), b1 = bfhi(x2r);
          *(LAS unsigned*)(lds + SA_QS + (t * 8 + h) * SA_KP + (256 + j0) * 2) = pk2((a0 * c0 - b0 * s0) * SM_SCALE_LOG2, (a1 * c1 - b1 * s1) * SM_SCALE_LOG2);
          *(LAS unsigned*)(lds + SA_QS + (t * 8 + h) * SA_KP + (256 + 32 + j0) * 2) = pk2((a0 * s0 + b0 * c0) * SM_SCALE_LOG2, (a1 * s1 + b1 * c1) * SM_SCALE_LOG2); }
    }
    LDS_WAIT(); __syncthreads();
#define SA_BAR() WG_BAR()
    f32x16 oacc;
#pragma unroll
    for (int r = 0; r < 16; ++r) oacc[r] = 0.f;
    float m_run = -1e30f, lsum = 0.f, m_own0 = -1e30f, m_own1 = -1e30f;
#define SA_STORE() do { \
        _Pragma("unroll") for (int i_ = 0; i_ < 16; ++i_) { const int c_ = tid + 512 * i_; u32x2 t_; t_.x = pk2(rl[i_].x, rl[i_].y); t_.y = pk2(rl[i_].z, rl[i_].w); \
            *(LAS u32x2*)(lds + SA_KN + (c_ >> 6) * SA_KP + 8 * (c_ & 63)) = t_; } \
        _Pragma("unroll") for (int i_ = 0; i_ < 4; ++i_) { const int c_ = tid + 512 * i_; u32x2 t_; t_.x = pk2(rr[i_].x, rr[i_].y); t_.y = pk2(rr[i_].z, rr[i_].w); \
            *(LAS u32x2*)(lds + SA_KN + (c_ >> 4) * SA_KP + 512 + 8 * (c_ & 15)) = t_; } } while (0)
    const int c16 = lane & 15, q4 = lane >> 4;
    const unsigned kaddr = (unsigned)(size_t)(lds + SA_KN + (16 * w + c16) * SA_KP + q4 * 16);
    const unsigned qaddr = (unsigned)(size_t)(lds + SA_QS + c16 * SA_KP + q4 * 16);
    LAS float* MXw = (LAS float*)(lds + SA_MX) + w * 32 + c16;
    LAS float* PSw = (LAS float*)(lds + SA_PS) + w * 32 + c16;
    const LAS float* MXo = (const LAS float*)(lds + SA_MX) + c16;
    const LAS float* PSn = (const LAS float*)(lds + SA_PS) + qi;
    LAS unsigned char* ptw = lds + SA_PT + c16 * SA_PP + (16 * w + 4 * q4) * 2;
    const unsigned paddr = (unsigned)(size_t)(lds + SA_PT + qi * SA_PP + kh * 16);
    const unsigned va0 = (unsigned)(size_t)(lds + SA_KN + (8 * (q4 >> 1) + (c16 >> 2)) * SA_KP + (32 * w + 16 * (q4 & 1) + 4 * (c16 & 3)) * 2);
    const unsigned va1 = va0 + 64 * SA_KP;
#define SA_COMPUTE(special) do { \
        f32x4 s0_ = {0.f, 0.f, 0.f, 0.f}, s1_ = {0.f, 0.f, 0.f, 0.f}; \
        { bf16x8 kr_[3], qa_[3], qb_[3]; \
          ds_read128<0>(kr_[0], kaddr); ds_read128<0>(qa_[0], qaddr); ds_read128<16 * SA_KP>(qb_[0], qaddr); \
          ds_read128<64>(kr_[1], kaddr); ds_read128<64>(qa_[1], qaddr); ds_read128<64 + 16 * SA_KP>(qb_[1], qaddr); \
          ds_read128<128>(kr_[2], kaddr); ds_read128<128>(qa_[2], qaddr); ds_read128<128 + 16 * SA_KP>(qb_[2], qaddr); \
          sa_qk_steps<0>(kr_, qa_, qb_, kaddr, qaddr, s0_, s1_); } \
        if (special) { const int t0_ = c16 >> 3, t1_ = (16 + c16) >> 3; \
            _Pragma("unroll") for (int r_ = 0; r_ < 4; ++r_) { if (16 * w + 4 * q4 + r_ > t0_) s0_[r_] = -INFINITY; if (16 * w + 4 * q4 + r_ > t1_) s1_[r_] = -INFINITY; } } \
        { float mx0_ = fmaxf(fmaxf(s0_[0], s0_[1]), fmaxf(s0_[2], s0_[3])), mx1_ = fmaxf(fmaxf(s1_[0], s1_[1]), fmaxf(s1_[2], s1_[3])); \
          mx0_ = fmaxf(mx0_, __shfl_xor(mx0_, 16)); mx1_ = fmaxf(mx1_, __shfl_xor(mx1_, 16)); mx0_ = fmaxf(mx0_, __shfl_xor(mx0_, 32)); mx1_ = fmaxf(mx1_, __shfl_xor(mx1_, 32)); \
          if (q4 == 0) { MXw[0] = mx0_; MXw[16] = mx1_; } } \
        SA_BAR(); \
        { float mt0_ = MXo[0], mt1_ = MXo[16]; \
          _Pragma("unroll") for (int w_ = 1; w_ < 8; ++w_) { mt0_ = fmaxf(mt0_, MXo[32 * w_]); mt1_ = fmaxf(mt1_, MXo[32 * w_ + 16]); } \
          m_own0 = fmaxf(m_own0, mt0_); m_own1 = fmaxf(m_own1, mt1_); \
          const float a0_ = fast_exp2(s0_[0] - m_own0), a1_ = fast_exp2(s0_[1] - m_own0), a2_ = fast_exp2(s0_[2] - m_own0), a3_ = fast_exp2(s0_[3] - m_own0); \
          const float b0_ = fast_exp2(s1_[0] - m_own1), b1_ = fast_exp2(s1_[1] - m_own1), b2_ = fast_exp2(s1_[2] - m_own1), b3_ = fast_exp2(s1_[3] - m_own1); \
          float ps0_ = (a0_ + a1_) + (a2_ + a3_), ps1_ = (b0_ + b1_) + (b2_ + b3_); \
          ps0_ += __shfl_xor(ps0_, 16); ps1_ += __shfl_xor(ps1_, 16); ps0_ += __shfl_xor(ps0_, 32); ps1_ += __shfl_xor(ps1_, 32); \
          if (q4 == 0) { PSw[0] = ps0_; PSw[16] = ps1_; } \
          u32x2 pw_; pw_.x = pk2(a0_, a1_); pw_.y = pk2(a2_, a3_); *(LAS u32x2*)ptw = pw_; pw_.x = pk2(b0_, b1_); pw_.y = pk2(b2_, b3_); *(LAS u32x2*)(ptw + 16 * SA_PP) = pw_; } \
        SA_BAR(); \
        { const float m_new_ = (lane & 16) ? m_own1 : m_own0; const float alpha_ = fast_exp2(m_run - m_new_); m_run = m_new_; \
          float sum_ = PSn[0]; \
          _Pragma("unroll") for (int w_ = 1; w_ < 8; ++w_) sum_ += PSn[32 * w_]; \
          lsum = lsum * alpha_ + sum_; \
          _Pragma("unroll") for (int r_ = 0; r_ < 16; ++r_) oacc[r_] *= alpha_; \
          bf16x8 pf_[3]; u32x2 ta_[3], tb_[3]; \
          ds_read128<0>(pf_[0], paddr); ds_read_tr64<0>(ta_[0], va0); ds_read_tr64<4 * SA_KP>(tb_[0], va0); \
          ds_read128<32>(pf_[1], paddr); ds_read_tr64<16 * SA_KP>(ta_[1], va0); ds_read_tr64<20 * SA_KP>(tb_[1], va0); \
          ds_read128<64>(pf_[2], paddr); ds_read_tr64<32 * SA_KP>(ta_[2], va0); ds_read_tr64<36 * SA_KP>(tb_[2], va0); \
          sa_pv_steps<0>(pf_, ta_, tb_, paddr, va0, va1, oacc); } \
    } while (0)
    for (int jt = 0; jt < 32; ++jt) {
        SA_STORE();
        if (jt + 1 < 32) SA_LOAD(jt + 1);
        SA_BAR();
        SA_COMPUTE(false); SA_BAR();
    }
    if (sp == 1) {
        for (int i = tid; i < 16 * SA_KP / 16; i += 512) *(LAS u32x4*)(lds + SA_KN + i * 16) = (u32x4){0u, 0u, 0u, 0u};
        SA_BAR();
        if (tid < 4 * 40) { const int t = tid / 40, ch = tid % 40;
            const u32x4 v = ch < 32 ? *(const u32x4*)(LATB + (row0 + t) * KVL + 8 * ch) : *(const u32x4*)(KRB + (row0 + t) * ROPE + 8 * (ch - 32));
            *(LAS u32x4*)(lds + SA_KN + t * SA_KP + 16 * ch) = v; }
        SA_BAR();
        SA_COMPUTE(true); SA_BAR();
    }
#undef SA_LOAD
#undef SA_STORE
#undef SA_COMPUTE
#undef SA_BAR
    if (w == 0 && kh == 0) { PART[qi] = m_run; PART[32 + qi] = lsum; }
#pragma unroll
    for (int q = 0; q < 4; ++q) { f32x4 v; v.x = oacc[4 * q]; v.y = oacc[4 * q + 1]; v.z = oacc[4 * q + 2]; v.w = oacc[4 * q + 3];
        *(f32x4*)(PART + 64 + qi * 256 + 32 * w + 8 * q + 4 * kh) = v; }
    VM_WAIT(); __syncthreads();
}
constexpr int CB_P = 528;
__device__ __forceinline__ void sample_combine(const Args& a, LAS unsigned char* lds, int s, int hh) {
    int tid_ = threadIdx.x; asm volatile("" : "+v"(tid_)); const int tid = tid_, lane = tid & 63, w = __builtin_amdgcn_readfirstlane(tid >> 6), qi = lane & 31, kh = lane >> 5;
    const float* P0 = (const float*)(a.ws + WS_PART) + (size_t)(s * 2) * PART_STRIDE; const float* P1 = P0 + PART_STRIDE;
    const bf16_t* C1 = (const bf16_t*)(a.ws + WS_C1); bf16_t* OG = (bf16_t*)(a.ws + WS_OG); const bf16_t* WUV = (const bf16_t*)(a.ws + WS_WUV);
    const int h = 4 * hh + (w & 3), vb0 = 2 * (w >> 2);
    bf16x8 afn[16];
#pragma unroll
    for (int st = 0; st < 16; ++st) afn[st] = *(const bf16x8*)(WUV + (size_t)(h * 128 + 32 * vb0 + qi) * 256 + 16 * st + 8 * kh);
#pragma unroll
    for (int k = 0; k < 2; ++k) { const int i = tid + 512 * k, ri = i >> 6, dq = i & 63, n = (ri >> 2) * 8 + 4 * hh + (ri & 3);
        const f32x4 a0 = *(const f32x4*)(P0 + 64 + n * 256 + 4 * dq), a1 = *(const f32x4*)(P1 + 64 + n * 256 + 4 * dq);
        const float m0 = P0[n], m1 = P1[n], l0 = P0[32 + n], l1 = P1[32 + n]; const float mm = fmaxf(m0, m1), w0 = fast_exp2(m0 - mm), w1 = fast_exp2(m1 - mm); const float inv = 1.0f / (l0 * w0 + l1 * w1);
        u32x2 o; o.x = pk2((a0.x * w0 + a1.x * w1) * inv, (a0.y * w0 + a1.y * w1) * inv); o.y = pk2((a0.z * w0 + a1.z * w1) * inv, (a0.w * w0 + a1.w * w1) * inv);
        *(LAS u32x2*)(lds + n * CB_P + 8 * dq) = o; }
    LDS_WAIT(); __syncthreads();
    const size_t row0 = (size_t)MP + (size_t)s * 4;
    bf16x8 bq[16];
#pragma unroll
    for (int st = 0; st < 16; ++st) { bf16x8 z = {0, 0, 0, 0, 0, 0, 0, 0}; if (qi < 4) z = *(const LAS bf16x8*)(lds + (qi * 8 + h) * CB_P + (16 * st + 8 * kh) * 2); bq[st] = z; }
    for (int vb = vb0; vb < vb0 + 2; ++vb) {
        f32x16 acc;
#pragma unroll
        for (int r = 0; r < 16; ++r) acc[r] = 0.f;
        bf16x8 af[16];
#pragma unroll
        for (int st = 0; st < 16; ++st) af[st] = afn[st];
        if (vb + 1 < vb0 + 2) {
#pragma unroll
            for (int st = 0; st < 16; ++st) afn[st] = *(const bf16x8*)(WUV + (size_t)(h * 128 + 32 * (vb + 1) + qi) * 256 + 16 * st + 8 * kh);
        }
#pragma unroll
        for (int st = 0; st < 16; ++st) acc = __builtin_amdgcn_mfma_f32_32x32x16_bf16(af[st], bq[st], acc, 0, 0, 0);
        u32x2 gg[4];
#pragma unroll
        for (int rq = 0; rq < 4; ++rq) gg[rq] = *(const u32x2*)(C1 + (row0 + (qi & 3)) * LDC1 + QL + h * 128 + 32 * vb + 8 * rq + 4 * kh);
        if (qi < 4) {
#pragma unroll
            for (int rq = 0; rq < 4; ++rq) { const int v0 = h * 128 + 32 * vb + 8 * rq + 4 * kh;
                const u32x2 gr = gg[rq];
                u32x2 o; o.x = pk2(acc[4 * rq] * siluf_(bflo(gr.x)), acc[4 * rq + 1] * siluf_(bfhi(gr.x))); o.y = pk2(acc[4 * rq + 2] * siluf_(bflo(gr.y)), acc[4 * rq + 3] * siluf_(bfhi(gr.y)));
                *(u32x2*)(OG + (row0 + qi) * D + v0) = o; }
        }
    }
    __syncthreads();
}

constexpr int NPHASE = 21;
__global__ void __launch_bounds__(512, 2) yoco_fwd(Args a) {
    extern __shared__ __attribute__((aligned(16))) unsigned char lds_raw[];
    LAS unsigned char* lds = (LAS unsigned char*)lds_raw;
    const int tid = threadIdx.x;
    const int G = gridDim.x, wg = blockIdx.x;
    const int ngw = G * 8, gthreads = G * 512;
#define OPQ_TID() int tq_ = threadIdx.x; asm volatile("" : "+v"(tq_)); const int lane = tq_ & 63, wave = __builtin_amdgcn_readfirstlane(tq_ >> 6), gw = wg * 8 + wave, gtid = wg * 512 + tq_; (void)lane; (void)gw; (void)gtid; (void)wave
    volatile LAS unsigned* ctlw = (volatile LAS unsigned*)(lds + LDS_CTL_OFF);
    if (tid < 4) ctlw[tid] = 0u;
    __syncthreads();
    unsigned* barw = (unsigned*)(a.ws + WS_CTL) + 1024;
    XcdBarrier bar; bar.bar = barw; bar.x = 0; bar.st = ctlw;
    const int lo = a.ph_lo, hi = a.ph_hi;
    const bool multi = (hi - lo) > 1;
    if (multi) bar = xcd_barrier_post(barw, ctlw);
    int ph = 0;
#define IN(k) (lo <= (k) && (k) < hi)
#define SEAM(k) do { if (IN(k) && IN((k) + 1)) xcd_barrier(bar); } while (0)
    unsigned char* ws = a.ws;
#define XB ((bf16_t*)(ws + WS_XB))
#define X ((float*)(ws + WS_X))
#define SSQ ((float*)(ws + WS_SSQ))
#define UZ ((bf16_t*)(ws + WS_UZ))
#define YG ((bf16_t*)(ws + WS_YG))
#define VB ((bf16_t*)(ws + WS_VB))
#define C1 ((bf16_t*)(ws + WS_C1))
#define CQN ((bf16_t*)(ws + WS_CQN))
#define LATB ((bf16_t*)(ws + WS_LATB))
#define QB ((bf16_t*)(ws + WS_Q))
#define KN ((bf16_t*)(ws + WS_KN))
#define VT ((bf16_t*)(ws + WS_VT))
#define OG ((bf16_t*)(ws + WS_OG))

    if (IN(ph)) {
        _Pragma("nounroll") for (int rep = 0; rep < REP_PRO; ++rep) { OPQ_TID(); prologue_phase(a, lds, gw, ngw, wave, lane, gtid, gthreads); }
    }
    SEAM(ph); ++ph;
    for (int i = 0; i < 2; ++i) {
        if (IN(ph)) {
            _Pragma("nounroll") for (int rep = 0; rep < REP_G1; ++rep) {
            { pg8::Gemm g{XB, (const bf16_t*)(ws + WS_WIN) + (size_t)i * 4096 * 1024, MP, 4096, 1024}; pg8::StaticOrder S; { int wgq_ = blockIdx.x; asm volatile("" : "+s"(wgq_)); S.init(MP, 4096, G, wgq_); }
              pg8::EpiScale<true> E{UZ, 4096, SSQ, 1.0f / D}; pg8::gemm_phase<pg8::EpiScale<true>, pg8::StaticOrder, true, true>(lds, g, S, E); }
            { sk::SkScale<true> E{UZ, 4096, SSQ, 1.0f / D}; for (int rs_ = 0; rs_ < REP_SK; ++rs_) sk::gemm(lds, XB + (size_t)MP * 1024, (const bf16_t*)(ws + WS_WIN) + (size_t)i * 4096 * 1024, 1024, 64, E, wg, G); } }
        }
        SEAM(ph); ++ph;
        if (IN(ph)) { _Pragma("nounroll") for (int rep = 0; rep < REP_SCAN; ++rep) scan_phase(a, i, lds, wg, G); }
        SEAM(ph); ++ph;
        if (IN(ph)) {
            _Pragma("nounroll") for (int rep = 0; rep < REP_G2; ++rep) {
            { pg8::Gemm g{YG, (const bf16_t*)(ws + WS_WGLU) + (size_t)i * 4096 * 2048, MP, 4096, 2048}; pg8::StaticOrder S; { int wgq_ = blockIdx.x; asm volatile("" : "+s"(wgq_)); S.init(MP, 4096, G, wgq_); }
              pg8::EpiGlu E{VB, UZ, a.b_glu + (size_t)i * 4096}; pg8::gemm_phase<pg8::EpiGlu, pg8::StaticOrder, true, true>(lds, g, S, E); }
            { sk::SkGlu E{VB, UZ, a.b_glu + (size_t)i * 4096}; for (int rs_ = 0; rs_ < REP_SK; ++rs_) sk::gemm(lds, YG + (size_t)MP * 2048, (const bf16_t*)(ws + WS_WGLU) + (size_t)i * 4096 * 2048, 2048, 64, E, wg, G); } }
        }
        SEAM(ph); ++ph;
        if (IN(ph)) { { pg8::Gemm g{VB, (const bf16_t*)(ws + WS_WOUT) + (size_t)i * 1024 * 2048, MP, 1024, 2048}; pg8::StaticOrder S; { int wgq_ = blockIdx.x; asm volatile("" : "+s"(wgq_)); S.init(MP, 1024, G, wgq_); }
            pg8::EpiRes E{X, XB, SSQ, i == 0 ? a.x_prompt : nullptr, a.x_sample}; pg8::gemm_phase<pg8::EpiRes, pg8::StaticOrder, true, true>(lds, g, S, E); }
            { sk::SkRes E{X, XB, SSQ, i == 0 ? a.x_sample : nullptr}; sk::gemm(lds, VB + (size_t)MP * 2048, (const bf16_t*)(ws + WS_WOUT) + (size_t)i * 1024 * 2048, 2048, 16, E, wg, G); } }
        SEAM(ph); ++ph;
    }
    for (int j = 0; j < 2; ++j) {
        if (IN(ph)) {
            _Pragma("nounroll") for (int rep = 0; rep < REP_M1; ++rep) {
            const int N1 = j == 0 ? N1A : N1B;
            { pg8::Gemm g{XB, (const bf16_t*)(ws + WS_WINB) + (size_t)j * 1792 * 1024, MP, N1, 1024}; pg8::StaticOrder S; { int wgq_ = blockIdx.x; asm volatile("" : "+s"(wgq_)); S.init(MP, N1, G, wgq_); }
              pg8::EpiScale<true, 0, true> E{C1, LDC1, SSQ, 1.0f / D, (float*)(ws + WS_SSQ2)}; pg8::gemm_phase<pg8::EpiScale<true, 0, true>, pg8::StaticOrder, true, true>(lds, g, S, E); }
            { sk::SkScale<true, true> E{C1, LDC1, SSQ, 1.0f / D, (float*)(ws + WS_SSQ2)}; for (int rs_ = 0; rs_ < REP_SK; ++rs_) sk::gemm(lds, XB + (size_t)MP * 1024, (const bf16_t*)(ws + WS_WINB) + (size_t)j * 1792 * 1024, 1024, N1 / 64, E, wg, G); } }
        }
        SEAM(ph); ++ph;
        if (j == 0) {
        if (IN(ph)) { _Pragma("nounroll") for (int rep = 0; rep < REP_THIN; ++rep) { OPQ_TID(); t1_phase(a, j, gw, ngw, lane); } }
        SEAM(ph); ++ph;
        }
        if (IN(ph)) {
            _Pragma("nounroll") for (int rep = 0; rep < REP_M2; ++rep) {
            { pg8::Gemm g{C1, (const bf16_t*)(ws + WS_WUQ) + (size_t)j * 1536 * 384, MP, 1536, 384, LDC1}; pg8::StaticOrder S; { int wgq_ = blockIdx.x; asm volatile("" : "+s"(wgq_)); S.init(MP, 1536, G, wgq_); }
              pg8::EpiScale<true> E{QB, 1536, (const float*)(ws + WS_SSQ2), 1.0f / QL}; pg8::gemm_phase<pg8::EpiScale<true>, pg8::StaticOrder, true, true>(lds, g, S, E); }
            { sk::SkScale<true> E{QB, 1536, (const float*)(ws + WS_SSQ2), 1.0f / QL}; for (int rs_ = 0; rs_ < REP_SK; ++rs_) sk::gemm(lds, C1 + (size_t)MP * LDC1, (const bf16_t*)(ws + WS_WUQ) + (size_t)j * 1536 * 384, 384, 24, E, wg, G, LDC1); }
            if (j == 0) {
                { pg8::Gemm g{LATB, (const bf16_t*)(ws + WS_WUK), MP, 1024, 256}; pg8::StaticOrder S; { int wgq_ = blockIdx.x; asm volatile("" : "+s"(wgq_)); S.init(MP, 1024, G, wgq_); }
                  pg8::EpiScale<false, 1> E{KN, 1024, nullptr, 0.f}; pg8::gemm_phase<pg8::EpiScale<false, 1>, pg8::StaticOrder, true, true>(lds, g, S, E); }
                { pg8::Gemm g{(const bf16_t*)(ws + WS_WUV), LATB, 1024, MP, 256}; pg8::StaticOrder S; { int wgq_ = blockIdx.x; asm volatile("" : "+s"(wgq_)); S.init(1024, MP, G, wgq_); }
                  pg8::EpiScale<false, 2> E{VT, MP, nullptr, 0.f}; pg8::gemm_phase<pg8::EpiScale<false, 2>, pg8::StaticOrder, true, true>(lds, g, S, E); }
            } }
        }
        SEAM(ph); ++ph;
        if (IN(ph)) {
            _Pragma("nounroll") for (int rep = 0; rep < REP_ATTP; ++rep)
            for (int it = ((wg & 7) * (G >> 3) + (wg >> 3)); it < 512; it += G) { const int x = it & 3, h = (it >> 2) & 7, b = it >> 5;
                attn_prompt_block(a, lds, b, h, 7 - x); attn_prompt_block(a, lds, b, h, x); }
            _Pragma("nounroll") for (int rep = 0; rep < REP_ATTS; ++rep)
            for (int it = wg; it < 256; it += G) attn_sample_unit(a, lds, it >> 1, it & 1);
        }
        SEAM(ph); ++ph;
        if (IN(ph)) { _Pragma("nounroll") for (int rep = 0; rep < REP_THIN; ++rep) for (int it = wg; it < 256; it += G) sample_combine(a, lds, it >> 1, it & 1); }
        SEAM(ph); ++ph;
        if (IN(ph)) { { pg8::Gemm g{OG, (const bf16_t*)(ws + WS_WOUTB) + (size_t)j * 1024 * 1024, MP, 1024, 1024}; pg8::StaticOrder S; { int wgq_ = blockIdx.x; asm volatile("" : "+s"(wgq_)); S.init(MP, 1024, G, wgq_); }
            pg8::EpiRes E{X, XB, SSQ, nullptr, nullptr}; pg8::gemm_phase<pg8::EpiRes, pg8::StaticOrder, true, true>(lds, g, S, E); }
            { sk::SkRes E{X, XB, SSQ, nullptr}; sk::gemm(lds, OG + (size_t)MP * 1024, (const bf16_t*)(ws + WS_WOUTB) + (size_t)j * 1024 * 1024, 1024, 16, E, wg, G); } }
        SEAM(ph); ++ph;
    }
    if (IN(ph)) { _Pragma("nounroll") for (int rep = 0; rep < REP_THIN; ++rep) { OPQ_TID(); final_phase(a, gw, ngw, lane); } }
#undef IN
#undef SEAM
#undef XB
#undef X
#undef SSQ
#undef UZ
#undef YG
#undef VB
#undef C1
#undef CQN
#undef LATB
#undef QB
#undef KN
#undef VT
#undef OG
}

extern "C" void kernel_launch(void* const* d_in, const int* in_sizes, int n_in, void* d_out, int out_size, void* d_ws, size_t ws_size, hipStream_t stream) {
    static int grid = 0;
    if (grid == 0) {
        if (n_in != 31 || ws_size < WS_END) { fprintf(stderr, "kernel_launch: unexpected inputs (n_in %d, ws %zu)\n", n_in, ws_size); grid = -1; return; }
        int dev = 0, cus = 0, per_cu = 0;
        if (hipGetDevice(&dev) != hipSuccess || hipDeviceGetAttribute(&cus, hipDeviceAttributeMultiprocessorCount, dev) != hipSuccess) { grid = -1; return; }
        if (hipFuncSetAttribute((const void*)yoco_fwd, hipFuncAttributeMaxDynamicSharedMemorySize, LDS_BYTES) != hipSuccess) { fprintf(stderr, "kernel_launch: hipFuncSetAttribute failed\n"); grid = -1; return; }
        if (hipOccupancyMaxActiveBlocksPerMultiprocessor(&per_cu, (const void*)yoco_fwd, 512, LDS_BYTES) != hipSuccess || per_cu < 1) { fprintf(stderr, "kernel_launch: occupancy query says %d\n", per_cu); }
        (void)hipGetLastError();
        grid = cus;
    }
    if (grid < 0) return;
    (void)hipMemsetAsync((char*)d_ws + WS_CTL, 0, CTL_BYTES, stream);
    Args a{};
    const float* const* f = (const float* const*)d_in;
    a.x_prompt = f[0]; a.x_sample = f[1]; a.cache_latent = f[2]; a.cache_krope = f[3]; a.page_table = (const int*)d_in[4]; a.state_re = f[5]; a.state_im = f[6];
    a.norm_a = f[7]; a.w_in_a = f[8]; a.a_re = f[9]; a.a_im = f[10]; a.log_dt = f[11]; a.b_re = f[12]; a.b_im = f[13]; a.c_re = f[14]; a.c_im = f[15]; a.d_skip = f[16];
    a.w_glu = f[17]; a.b_glu = f[18]; a.w_out_a = f[19]; a.norm_kv = f[20]; a.w_dkv = f[21]; a.norm_latent = f[22]; a.w_uk = f[23]; a.w_uv = f[24];
    a.norm_b = f[25]; a.w_in_b = f[26]; a.norm_q = f[27]; a.w_uq = f[28]; a.w_out_b = f[29]; a.norm_f = f[30];
    a.out = (float*)d_out; a.ws = (unsigned char*)d_ws;
#if MK_ONE_LAUNCH
    a.ph_lo = 0; a.ph_hi = NPHASE;
    hipLaunchKernelGGL(yoco_fwd, dim3(grid), dim3(512), LDS_BYTES, stream, a);
#else
    for (int p = 0; p < NPHASE; ++p) { a.ph_lo = p; a.ph_hi = p + 1; hipLaunchKernelGGL(yoco_fwd, dim3(grid), dim3(512), LDS_BYTES, stream, a); }
#endif
}
```

```cpp
#include <hip/hip_runtime.h>
#include <cstdint>
#include <cstdio>

#ifndef REP_PRO
#define REP_PRO 1
#endif
#ifndef REP_G1
#define REP_G1 1
#endif
#ifndef REP_SCAN
#define REP_SCAN 1
#endif
#ifndef REP_G2
#define REP_G2 1
#endif
#ifndef REP_ATTP
#define REP_ATTP 1
#endif
#ifndef REP_ATTS
#define REP_ATTS 1
#endif
#ifndef REP_M1
#define REP_M1 1
#endif
#ifndef REP_M2
#define REP_M2 1
#endif
#ifndef REP_THIN
#define REP_THIN 1
#define REP_SK 1
#endif
#ifndef MK_ONE_LAUNCH
#define MK_ONE_LAUNCH 1
#endif

#define LAS __attribute__((address_space(3)))
typedef unsigned short bf16_t;
typedef short bf16x8 __attribute__((ext_vector_type(8)));
typedef float f32x2 __attribute__((ext_vector_type(2)));
typedef float f32x4 __attribute__((ext_vector_type(4)));
typedef float f32x16 __attribute__((ext_vector_type(16)));
typedef unsigned u32x2 __attribute__((ext_vector_type(2)));
typedef unsigned u32x4 __attribute__((ext_vector_type(4)));

constexpr int D = 1024, MP = 32768, MS = 512, M = MP + MS, SEQ = 2048;
constexpr int SSMW = 2048, NG = 128, ST = 64;
constexpr int NH = 8, KVL = 256, QL = 384, ROPE = 64;
constexpr int N1A = 1792, N1B = 1536;
constexpr int LDC1 = 1792;
constexpr int NPAGES = 64, PAGE = 128;
constexpr float EPS = 1e-6f;
constexpr float SM_SCALE_LOG2 = 0.07216878364870322f * 1.4426950408889634f;

constexpr size_t O_YP = 0, O_YS = 33554432, O_LATP = 34078720, O_KRP = 42467328, O_LATS = 44564480, O_KRS = 44695552,
                 O_HPR = 44728320, O_HPI = 44990464, O_HSR = 45252608, O_HSI = 47349760;

constexpr size_t MiB = 1u << 20;
constexpr size_t WS_CTL = 0, CTL_BYTES = 1 * MiB;
constexpr size_t WS_WIN = 2 * MiB;
constexpr size_t WS_WGLU = WS_WIN + 16 * MiB;
constexpr size_t WS_WOUT = WS_WGLU + 32 * MiB;
constexpr size_t WS_WINB = WS_WOUT + 8 * MiB;
constexpr size_t WS_WUQ = WS_WINB + 7 * MiB;
constexpr size_t WS_WUK = WS_WUQ + 3 * MiB;
constexpr size_t WS_WUV = WS_WUK + 1 * MiB;
constexpr size_t WS_WUKB = WS_WUV + 1 * MiB;
constexpr size_t WS_WOUTB = WS_WUKB + 1 * MiB;
constexpr size_t WS_ROPE = WS_WOUTB + 4 * MiB;
constexpr size_t WS_SCP = WS_ROPE + 1 * MiB;
constexpr size_t WS_SSQ2 = WS_SCP + 1 * MiB;
constexpr size_t WS_X = 80 * MiB;
constexpr size_t WS_XB = WS_X + 130 * MiB;
constexpr size_t WS_SSQ = WS_XB + 65 * MiB;
constexpr size_t WS_UZ = WS_SSQ + 3 * MiB;
constexpr size_t WS_YG = WS_UZ + 260 * MiB;
constexpr size_t WS_VB = WS_YG + 130 * MiB;
constexpr size_t WS_C1 = WS_VB + 130 * MiB;
constexpr size_t WS_CQN = WS_C1 + 114 * MiB;
constexpr size_t WS_LATB = WS_CQN + 25 * MiB;
constexpr size_t WS_KRB = WS_LATB + 17 * MiB;
constexpr size_t WS_Q = WS_KRB + 5 * MiB;
constexpr size_t WS_KN = WS_Q + 98 * MiB;
constexpr size_t WS_VT = WS_KN + 64 * MiB;
constexpr size_t WS_OG = WS_VT + 64 * MiB;
constexpr size_t WS_PART = WS_OG + 65 * MiB;
constexpr size_t WS_END = WS_PART + 9 * MiB;
constexpr int PART_STRIDE = 64 + 256 * 32;

constexpr int LDS_BYTES = 131072 + 1024;
constexpr int LDS_CTL_OFF = 131072;

typedef __bf16 bf16x2_t __attribute__((ext_vector_type(2)));
__device__ __forceinline__ unsigned pk2(float lo, float hi) { const f32x2 v = {lo, hi}; return __builtin_bit_cast(unsigned, __builtin_convertvector(v, bf16x2_t)); }
__device__ __forceinline__ float bflo(unsigned u) { return __uint_as_float(u << 16); }
__device__ __forceinline__ float bfhi(unsigned u) { return __uint_as_float(u & 0xffff0000u); }
__device__ __forceinline__ float bf1(bf16_t b) { return __uint_as_float(((unsigned)b) << 16); }
__device__ __forceinline__ bf16_t f2bf(float f) { return (bf16_t)(pk2(f, 0.f) & 0xffffu); }
__device__ __forceinline__ float wave_sum(float v) {
#pragma unroll
    for (int o = 1; o < 64; o <<= 1) v += __shfl_xor(v, o);
    return v;
}
__device__ __forceinline__ float fast_exp2(float x) { return __builtin_amdgcn_exp2f(x); }
__device__ __forceinline__ float fast_rcp(float x) { return __builtin_amdgcn_rcpf(x); }
__device__ __forceinline__ float sigmoidf_(float x) { return fast_rcp(1.0f + fast_exp2(-1.4426950408889634f * x)); }
__device__ __forceinline__ float siluf_(float x) { return x * sigmoidf_(x); }
__device__ __forceinline__ float glu3(float ga, float gb, float z) { const float e1 = fast_exp2(-1.4426950408889634f * gb), e2 = fast_exp2(-1.4426950408889634f * z); return (ga * z) * fast_rcp((1.0f + e1) * (1.0f + e2)); }
__device__ __forceinline__ float gelu_tanh(float x) { const float w = x * fmaf(x * x, -0.10294324f, -2.3022082f); return x * fast_rcp(1.0f + fast_exp2(w)); }
__device__ __forceinline__ float fma_np(float a, float b, float c) { float d; asm("v_fma_f32 %0, %1, %2, %3" : "=v"(d) : "v"(a), "v"(b), "v"(c)); return d; }
#define LDS_WAIT() asm volatile("s_waitcnt lgkmcnt(0)" ::: "memory")
#define VM_WAIT() asm volatile("s_waitcnt vmcnt(0)" ::: "memory")
#define WG_BAR() do { asm volatile("s_waitcnt lgkmcnt(0)" ::: "memory"); __builtin_amdgcn_s_barrier(); asm volatile("" ::: "memory"); } while (0)

namespace pg8 {
#define PG8_LAS __attribute__((address_space(3)))
constexpr int BM = 256, BK = 64, HALF = 128, HTB = HALF * BK * 2, STAGE_BYTES = 8 * HTB, NXCD = 8, WGM = 8;
__host__ __device__ __forceinline__ int lds_byte(int r, int c) { const int st = (r >> 4) * 2 + (c >> 5), rr = r & 15, cc = c & 31, ob = rr * 64 + cc * 2; return st * 1024 + (ob ^ (((ob >> 9) & 1) << 5)); }
__host__ __device__ __forceinline__ void stage_rc(int b, int& R, int& C) { const int st = b / 1024, sb = b % 1024, swz = sb ^ (((sb >> 9) & 1) << 5); R = (st >> 1) * 16 + swz / 64; C = (st & 1) * 32 + (swz % 64) / 2; }
__host__ __device__ __forceinline__ int perm32(int rho) { const int n = rho >> 4, i = rho & 15; return 8 * (i >> 2) + 4 * n + (i & 3); }
struct Unit { int pm, pn; };
struct Gemm { const bf16_t* A; const bf16_t* Bt; int M, N, K; int lda = 0; };
struct StaticOrder {
    int nM, nN, nwg, G, c;
    __host__ __device__ void init(int M_, int N_, int G_, int c_) { nM = M_ / BM; nN = N_ / BM; nwg = nM * nN; G = G_; c = c_; }
    __host__ __device__ bool next(int i, Unit& u) const {
        const long L = (long)i * G + c; if (L >= nwg) return false;
        int wgid = (int)L; { const int q = nwg / NXCD, r = nwg % NXCD, xcd = wgid % NXCD, off = wgid / NXCD; wgid = (xcd < r ? xcd * (q + 1) : r * (q + 1) + (xcd - r) * q) + off; }
        const int nig = WGM * nN, gid = wgid / nig, fm = gid * WGM, gsz = (nM - fm) < WGM ? (nM - fm) : WGM;
        u.pm = fm + ((wgid % nig) % gsz); u.pn = (wgid % nig) / gsz; return true;
    }
    __device__ __forceinline__ void a_ready(const Unit&) const {}
    __device__ __forceinline__ void done(const Unit&) const {}
};

template <bool HAS_SSQ, int LAYOUT = 0, bool EMIT = false> struct EpiScale {
    static constexpr bool PERM = true, AFTER_DRAIN = false;
    bf16_t* O; int ldc; const float* ssq; float invk; float* sq2 = nullptr;
    __device__ __forceinline__ void operator()(const f32x4 (&acc)[2][2][4][2], const Unit& u, int wr, int wc, int fr, int fq) const {
        const int row0 = u.pm * BM + wr * 64 + fr, col0 = u.pn * BM + wc * 32 + 8 * fq;
        float rr[8];
        if constexpr (HAS_SSQ) {
            f32x4 pv[8];
#pragma unroll
            for (int i = 0; i < 8; ++i) pv[i] = *(const f32x4*)(ssq + (size_t)(row0 + (i >> 2) * HALF + (i & 3) * 16) * 16 + 4 * fq);
#pragma unroll
            for (int i = 0; i < 8; ++i) { float s = (pv[i].x + pv[i].y) + (pv[i].z + pv[i].w); s += __shfl_xor(s, 16); s += __shfl_xor(s, 32); rr[i] = __builtin_amdgcn_rsqf(s * invk + EPS); }
        }
#pragma unroll
        for (int ai = 0; ai < 2; ++ai)
#pragma unroll
            for (int m = 0; m < 4; ++m) {
                const int row = row0 + ai * HALF + m * 16; const float r = HAS_SSQ ? rr[ai * 4 + m] : 1.f;
                if constexpr (EMIT) { if (u.pn < 2) {
                    const f32x4 a0 = acc[ai][0][m][0] * r, a1 = acc[ai][0][m][1] * r, b0 = acc[ai][1][m][0] * r, b1 = acc[ai][1][m][1] * r;
                    float s0 = ((a0[0] * a0[0] + a0[1] * a0[1]) + (a0[2] * a0[2] + a0[3] * a0[3])) + ((a1[0] * a1[0] + a1[1] * a1[1]) + (a1[2] * a1[2] + a1[3] * a1[3]));
                    float s1 = ((b0[0] * b0[0] + b0[1] * b0[1]) + (b0[2] * b0[2] + b0[3] * b0[3])) + ((b1[0] * b1[0] + b1[1] * b1[1]) + (b1[2] * b1[2] + b1[3] * b1[3]));
                    s0 += __shfl_xor(s0, 16); s1 += __shfl_xor(s1, 16); s0 += __shfl_xor(s0, 32); s1 += __shfl_xor(s1, 32);
                    if (fq == 0) { float* q2 = sq2 + (size_t)row * 16; if (u.pn == 0) q2[wc] = s0 + s1; else { q2[4 + wc] = s0; q2[8 + wc] = 0.f; q2[12 + wc] = 0.f; } } } }
#pragma unroll
                for (int bj = 0; bj < 2; ++bj) { const f32x4 v0 = acc[ai][bj][m][0] * r, v1 = acc[ai][bj][m][1] * r;
                    u32x4 w; w.x = pk2(v0[0], v0[1]); w.y = pk2(v0[2], v0[3]); w.z = pk2(v1[0], v1[1]); w.w = pk2(v1[2], v1[3]);
                    const int col = col0 + bj * HALF; size_t off;
                    if (LAYOUT == 0) off = (size_t)row * ldc + col;
                    else if (LAYOUT == 1) off = ((size_t)((row >> 11) * 8 + (col >> 7)) * 2048 + (row & 2047)) * 128 + (col & 127);
                    else off = ((size_t)(((col >> 11) * 8 + (row >> 7)) * 32 + ((col >> 6) & 31)) * 128 + (row & 127)) * 64 + (col & 63);
                    *(u32x4*)(O + off) = w; }
            }
    }
};
struct EpiGlu {
    static constexpr bool PERM = true, AFTER_DRAIN = false;
    bf16_t* V; const bf16_t* UZ; const float* bias;
    __device__ __forceinline__ void operator()(const f32x4 (&acc)[2][2][4][2], const Unit& u, int wr, int wc, int fr, int fq) const {
        const int row0 = u.pm * BM + wr * 64 + fr, j0 = u.pn * HALF + wc * 32 + 8 * fq;
        const f32x4 ba0 = *(const f32x4*)(bias + j0), ba1 = *(const f32x4*)(bias + j0 + 4), bb0 = *(const f32x4*)(bias + SSMW + j0), bb1 = *(const f32x4*)(bias + SSMW + j0 + 4);
        u32x4 zz[8];
#pragma unroll
        for (int i = 0; i < 8; ++i) zz[i] = *(const u32x4*)(UZ + (size_t)(row0 + (i >> 2) * HALF + (i & 3) * 16) * 4096 + SSMW + j0);
#pragma unroll
        for (int ai = 0; ai < 2; ++ai)
#pragma unroll
            for (int m = 0; m < 4; ++m) {
                const int row = row0 + ai * HALF + m * 16;
                const u32x4 zr = zz[ai * 4 + m];
                const f32x4 ga0 = acc[ai][0][m][0] + ba0, ga1 = acc[ai][0][m][1] + ba1, gb0 = acc[ai][1][m][0] + bb0, gb1 = acc[ai][1][m][1] + bb1;
                float z[8] = {bflo(zr.x), bfhi(zr.x), bflo(zr.y), bfhi(zr.y), bflo(zr.z), bfhi(zr.z), bflo(zr.w), bfhi(zr.w)};
                float o[8];
#pragma unroll
                for (int e = 0; e < 4; ++e) { o[e] = glu3(ga0[e], gb0[e], z[e]); o[4 + e] = glu3(ga1[e], gb1[e], z[4 + e]); }
                u32x4 w; w.x = pk2(o[0], o[1]); w.y = pk2(o[2], o[3]); w.z = pk2(o[4], o[5]); w.w = pk2(o[6], o[7]);
                *(u32x4*)(V + (size_t)row * SSMW + j0) = w;
            }
    }
};
struct EpiRes {
    static constexpr bool PERM = true, AFTER_DRAIN = false;
    float* X; bf16_t* XB; float* SSQ; const float* xin_p; const float* xin_s;
    __device__ __forceinline__ void operator()(const f32x4 (&acc)[2][2][4][2], const Unit& u, int wr, int wc, int fr, int fq) const {
        const int row0 = u.pm * BM + wr * 64 + fr, col0 = u.pn * BM + wc * 32 + 8 * fq;
#pragma unroll
        for (int ai = 0; ai < 2; ++ai) {
            u32x4 xo[4][2];
#pragma unroll
            for (int m = 0; m < 4; ++m) { const bf16_t* xs = XB + (size_t)(row0 + ai * HALF + m * 16) * D + col0;
#pragma unroll
                for (int bj = 0; bj < 2; ++bj) xo[m][bj] = *(const u32x4*)(xs + bj * HALF); }
#pragma unroll
            for (int m = 0; m < 4; ++m) {
                const int row = row0 + ai * HALF + m * 16; float ss = 0.f;
                bf16_t* xb = XB + (size_t)row * D + col0;
#pragma unroll
                for (int bj = 0; bj < 2; ++bj) { const u32x4 xr_ = xo[m][bj];
                    f32x4 x0, x1; x0[0] = bflo(xr_.x); x0[1] = bfhi(xr_.x); x0[2] = bflo(xr_.y); x0[3] = bfhi(xr_.y); x1[0] = bflo(xr_.z); x1[1] = bfhi(xr_.z); x1[2] = bflo(xr_.w); x1[3] = bfhi(xr_.w);
                    const f32x4 o0 = x0 + acc[ai][bj][m][0], o1 = x1 + acc[ai][bj][m][1];
                    u32x4 w; w.x = pk2(o0[0], o0[1]); w.y = pk2(o0[2], o0[3]); w.z = pk2(o1[0], o1[1]); w.w = pk2(o1[2], o1[3]); *(u32x4*)(xb + bj * HALF) = w;
                    ss += ((o0[0] * o0[0] + o0[1] * o0[1]) + (o0[2] * o0[2] + o0[3] * o0[3])) + ((o1[0] * o1[0] + o1[1] * o1[1]) + (o1[2] * o1[2] + o1[3] * o1[3])); }
                ss += __shfl_xor(ss, 16); ss += __shfl_xor(ss, 32);
                if (fq == 0) SSQ[(size_t)row * 16 + u.pn * 4 + wc] = ss;
            }
        }
    }
};

template <class Epi, class Sched, bool ALIGN_EPI = false, bool SP2 = false>
__device__ __forceinline__ void gemm_phase(PG8_LAS unsigned char* lds, const Gemm g, const Sched& S, const Epi& E) {
    int tid_ = threadIdx.x; asm volatile("" : "+v"(tid_));
    const int tid = tid_, wid = __builtin_amdgcn_readfirstlane(tid >> 6), lane = tid & 63, wr = wid >> 2, wc = wid & 3, fr = lane & 15, fq = lane >> 4;
    const int K = g.K, nt = K / BK, lda = g.lda ? g.lda : K;
    unsigned voffA[2], voffB[2];
#pragma unroll
    for (int i = 0; i < 2; ++i) { int R, C; stage_rc(tid * 16 + i * 8192, R, C); const int Rb = Epi::PERM ? ((R & ~31) + perm32(R & 31)) : R;
        voffA[i] = (unsigned)(R * lda + C) * 2u; voffB[i] = (unsigned)(Rb * K + C) * 2u; }
    const size_t kstep = (size_t)(BK * 2);
    const size_t hstep = (size_t)HALF * K * 2;
    const size_t tstep = 2 * hstep;
    const size_t hstepA = (size_t)HALF * lda * 2, tstepA = 2 * hstepA;
    const unsigned ldsw = (unsigned)wid * 1024u;
    const int aoff = lds_byte(wr * 64 + fr, fq * 8), boff = lds_byte(wc * 32 + fr, fq * 8);
#define PG8_SA(b, h) (((b) * 2 + (h)) * HTB)
#define PG8_SB(b, h) ((4 + (b) * 2 + (h)) * HTB)
#define PG8_STAGE(bufoff, gbase, voff) do { _Pragma("unroll") for (int _i = 0; _i < 2; ++_i) \
        __builtin_amdgcn_global_load_lds((const unsigned*)((const char*)(gbase) + (voff)[_i]), (PG8_LAS unsigned*)(lds + (bufoff) + ldsw + _i * 8192), 16, 0, 0); } while (0)
#define PG8_LDA(dst, b, h) do { _Pragma("unroll") for (int m = 0; m < 4; ++m) _Pragma("unroll") for (int k = 0; k < 2; ++k) dst[m][k] = *(const PG8_LAS bf16x8*)(lds + PG8_SA(b, h) + aoff + m * 2048 + k * 1024); } while (0)
#define PG8_LDB(dst, b, h) do { _Pragma("unroll") for (int n = 0; n < 2; ++n) _Pragma("unroll") for (int k = 0; k < 2; ++k) dst[n][k] = *(const PG8_LAS bf16x8*)(lds + PG8_SB(b, h) + boff + n * 2048 + k * 1024); } while (0)
#define PG8_MMA(ai, bj, At, Bt) do { __builtin_amdgcn_s_setprio(1); _Pragma("unroll") for (int m = 0; m < 4; ++m) _Pragma("unroll") for (int n = 0; n < 2; ++n) _Pragma("unroll") for (int k = 0; k < 2; ++k) \
        acc[ai][bj][m][n] = __builtin_amdgcn_mfma_f32_16x16x32_bf16(Bt[n][k], At[m][k], acc[ai][bj][m][n], 0, 0, 0); __builtin_amdgcn_s_setprio(0); } while (0)
#define PG8_WAIT_V(n) asm volatile("s_waitcnt vmcnt(" #n ")" ::: "memory")
#define PG8_WAIT_L(n) asm volatile("s_waitcnt lgkmcnt(" #n ")" ::: "memory")
#define PG8_BAR __builtin_amdgcn_s_barrier()
#define PG8_SCHED __builtin_amdgcn_sched_barrier(0)
    Unit cur, nxt; int ui = 0;
    if (!S.next(0, cur)) return;
    f32x4 acc[2][2][4][2];
#pragma unroll
    for (int a = 0; a < 2; ++a)
#pragma unroll
        for (int b = 0; b < 2; ++b)
#pragma unroll
            for (int m = 0; m < 4; ++m)
#pragma unroll
                for (int n = 0; n < 2; ++n) acc[a][b][m][n] = (f32x4){0.f, 0.f, 0.f, 0.f};
    bf16x8 At[4][2], B0[2][2], B1[2][2];
    const char* cA = (const char*)g.A + (size_t)cur.pm * tstepA; const char* cB = (const char*)g.Bt + (size_t)cur.pn * tstep;
    S.a_ready(cur);
    if constexpr (SP2) {
        PG8_STAGE(PG8_SB(0, 0), cB, voffB); PG8_STAGE(PG8_SB(0, 1), cB + hstep, voffB); PG8_STAGE(PG8_SA(0, 0), cA, voffA); PG8_STAGE(PG8_SA(0, 1), cA + hstepA, voffA);
        if (wr == 1) PG8_BAR;
        PG8_WAIT_V(2); PG8_BAR;
        PG8_STAGE(PG8_SB(1, 0), cB + kstep, voffB); PG8_STAGE(PG8_SA(1, 0), cA + kstep, voffA); PG8_STAGE(PG8_SB(1, 1), cB + hstep + kstep, voffB);
        PG8_WAIT_V(6); PG8_BAR;
    } else {
        PG8_STAGE(PG8_SB(0, 0), cB, voffB); PG8_STAGE(PG8_SA(0, 0), cA, voffA); PG8_STAGE(PG8_SB(0, 1), cB + hstep, voffB); PG8_STAGE(PG8_SA(0, 1), cA + hstepA, voffA);
        if (wr == 1) PG8_BAR;
        PG8_WAIT_V(4); PG8_BAR;
        PG8_STAGE(PG8_SB(1, 0), cB + kstep, voffB); PG8_STAGE(PG8_SA(1, 0), cA + kstep, voffA); PG8_STAGE(PG8_SB(1, 1), cB + hstep + kstep, voffB);
        PG8_WAIT_V(6); PG8_BAR;
    }
    for (;;) {
        const bool has_next = S.next(ui + 1, nxt);
        const char* nA = has_next ? (const char*)g.A + (size_t)nxt.pm * tstepA : cA; const char* nB = has_next ? (const char*)g.Bt + (size_t)nxt.pn * tstep : cB;
#pragma nounroll
        for (int t = 0; t < nt; t += 2) {
            const bool last = (t == nt - 2);
            const char* a1 = cA + (size_t)(t + 1) * kstep;
            const char* a2 = last ? nA : cA + (size_t)(t + 2) * kstep; const char* b2 = last ? nB : cB + (size_t)(t + 2) * kstep;
            const char* a3 = a2 + kstep; const char* b3 = b2 + kstep;
            if (last && has_next) S.a_ready(nxt);
            if constexpr (SP2) {
            PG8_LDB(B0, 0, 0); PG8_LDB(B1, 0, 1); PG8_SCHED; PG8_LDA(At, 0, 0); PG8_STAGE(PG8_SA(1, 1), a1 + hstepA, voffA);
            PG8_WAIT_V(8); PG8_WAIT_L(0); PG8_BAR; PG8_MMA(0, 0, At, B0); PG8_MMA(0, 1, At, B1); PG8_BAR; PG8_SCHED;
            PG8_LDA(At, 0, 1); PG8_STAGE(PG8_SB(0, 0), b2, voffB); PG8_STAGE(PG8_SB(0, 1), b2 + hstep, voffB); PG8_STAGE(PG8_SA(0, 0), a2, voffA);
            PG8_WAIT_V(8); PG8_WAIT_L(0); PG8_BAR; PG8_MMA(1, 0, At, B0); PG8_MMA(1, 1, At, B1); PG8_BAR; PG8_SCHED;
            PG8_LDB(B0, 1, 0); PG8_LDB(B1, 1, 1); PG8_SCHED; PG8_LDA(At, 1, 0); PG8_STAGE(PG8_SA(0, 1), a2 + hstepA, voffA);
            PG8_WAIT_V(8); PG8_WAIT_L(0); PG8_BAR; PG8_MMA(0, 0, At, B0); PG8_MMA(0, 1, At, B1); PG8_BAR; PG8_SCHED;
            PG8_LDA(At, 1, 1); PG8_STAGE(PG8_SB(1, 0), b3, voffB); PG8_STAGE(PG8_SB(1, 1), b3 + hstep, voffB); PG8_STAGE(PG8_SA(1, 0), a3, voffA);
            PG8_WAIT_V(8); PG8_WAIT_L(0); PG8_BAR; PG8_MMA(1, 0, At, B0); PG8_MMA(1, 1, At, B1); PG8_BAR; PG8_SCHED;
            } else {
            PG8_LDB(B0, 0, 0); PG8_SCHED; PG8_LDA(At, 0, 0); PG8_STAGE(PG8_SA(1, 1), a1 + hstepA, voffA);
            PG8_WAIT_L(8); PG8_BAR; PG8_WAIT_L(0); PG8_MMA(0, 0, At, B0); PG8_BAR; PG8_SCHED;
            PG8_LDB(B1, 0, 1); PG8_STAGE(PG8_SB(0, 0), b2, voffB);
            PG8_BAR; PG8_WAIT_L(0); PG8_MMA(0, 1, At, B1); PG8_BAR;
            PG8_LDA(At, 0, 1); PG8_STAGE(PG8_SA(0, 0), a2, voffA);
            PG8_BAR; PG8_WAIT_L(0); PG8_MMA(1, 0, At, B0); PG8_BAR; PG8_SCHED;
            PG8_STAGE(PG8_SB(0, 1), b2 + hstep, voffB);
            PG8_WAIT_V(6); PG8_BAR; PG8_MMA(1, 1, At, B1); PG8_BAR;
            PG8_LDB(B0, 1, 0); PG8_SCHED; PG8_LDA(At, 1, 0); PG8_STAGE(PG8_SA(0, 1), a2 + hstepA, voffA);
            PG8_WAIT_L(8); PG8_BAR; PG8_WAIT_L(0); PG8_MMA(0, 0, At, B0); PG8_BAR; PG8_SCHED;
            PG8_LDB(B1, 1, 1); PG8_STAGE(PG8_SB(1, 0), b3, voffB);
            PG8_BAR; PG8_WAIT_L(0); PG8_MMA(0, 1, At, B1); PG8_BAR;
            PG8_LDA(At, 1, 1); PG8_STAGE(PG8_SA(1, 0), a3, voffA);
            PG8_BAR; PG8_WAIT_L(0); PG8_MMA(1, 0, At, B0); PG8_BAR; PG8_SCHED;
            PG8_STAGE(PG8_SB(1, 1), b3 + hstep, voffB);
            PG8_WAIT_V(6); PG8_BAR; PG8_MMA(1, 1, At, B1); PG8_BAR;
            }
        }
        if constexpr (ALIGN_EPI) { if (wr == 0) PG8_BAR; }
        if constexpr (!Epi::AFTER_DRAIN) { E(acc, cur, wr, wc, fr, fq); S.done(cur); }
        if (!has_next) break;
#pragma unroll
        for (int a = 0; a < 2; ++a)
#pragma unroll
            for (int b = 0; b < 2; ++b)
#pragma unroll
                for (int m = 0; m < 4; ++m)
#pragma unroll
                    for (int n = 0; n < 2; ++n) acc[a][b][m][n] = (f32x4){0.f, 0.f, 0.f, 0.f};
        cur = nxt; cA = nA; cB = nB; ++ui;
        if constexpr (ALIGN_EPI) { if (wr == 1) PG8_BAR; }
    }
    PG8_WAIT_V(0);
    if constexpr (!ALIGN_EPI) { if (wr == 0) PG8_BAR; }
    PG8_BAR;
#undef PG8_SA
#undef PG8_SB
#undef PG8_STAGE
#undef PG8_LDA
#undef PG8_LDB
#undef PG8_MMA
#undef PG8_WAIT_V
#undef PG8_WAIT_L
#undef PG8_BAR
#undef PG8_SCHED
}
}

namespace sk {
constexpr int PITCH = 272, ABYTES = 128 * PITCH, BBYTES = 64 * PITCH, STG = ABYTES + BBYTES;
template <bool HAS_SSQ, bool EMIT = false> struct SkScale {
    bf16_t* O; int ldc; const float* ssq; float invk; float* sq2 = nullptr;
    __device__ __forceinline__ int brow_src(int nc, int brow) const { return nc * 64 + brow; }
    __device__ __forceinline__ void operator()(const f32x16& acc, int mr, int nc, int wr, int wc, int li, int kh, LAS unsigned char*) const {
        const size_t grow = (size_t)MP + mr * 128 + 32 * wr + li; float r = 1.f;
        if constexpr (HAS_SSQ) { const f32x4* sp = (const f32x4*)(ssq + grow * 16); const f32x4 p0 = sp[0], p1 = sp[1], p2 = sp[2], p3 = sp[3];
            r = __builtin_amdgcn_rsqf((((p0.x + p0.y) + (p0.z + p0.w)) + ((p1.x + p1.y) + (p1.z + p1.w)) + ((p2.x + p2.y) + (p2.z + p2.w)) + ((p3.x + p3.y) + (p3.z + p3.w))) * invk + EPS); }
        if constexpr (EMIT) { if (nc < 6) { float s = 0.f;
#pragma unroll
            for (int q = 0; q < 16; ++q) { const float t = acc[q] * r; s += t * t; }
            s += __shfl_xor(s, 32);
            if (kh == 0) { float* q2 = sq2 + grow * 16; q2[2 * nc + wc] = s; if (nc == 5) { float z0_ = 0.f; asm volatile("" : "+v"(z0_)); q2[12 + 2 * wc] = z0_; q2[13 + 2 * wc] = z0_; }     } } }
#pragma unroll
        for (int q = 0; q < 4; ++q) { u32x2 o; o.x = pk2(acc[4 * q] * r, acc[4 * q + 1] * r); o.y = pk2(acc[4 * q + 2] * r, acc[4 * q + 3] * r);
            *(u32x2*)(O + grow * ldc + nc * 64 + 32 * wc + 8 * q + 4 * kh) = o; }
    }
};
struct SkGlu {
    bf16_t* V; const bf16_t* UZ; const float* bias;
    __device__ __forceinline__ int brow_src(int nc, int brow) const { const int wcb = brow >> 5, c = brow & 31, q = c >> 3, hi = (c >> 2) & 1, e = c & 3;
        const int j = 32 * nc + 16 * wcb + 8 * (q >> 1) + 4 * hi + e, bj = q & 1; return 256 * (j >> 7) + 128 * bj + (j & 127); }
    __device__ __forceinline__ void operator()(const f32x16& acc, int mr, int nc, int wr, int wc, int li, int kh, LAS unsigned char*) const {
        const size_t grow = (size_t)MP + mr * 128 + 32 * wr + li;
#pragma unroll
        for (int p = 0; p < 2; ++p) { const int j0 = 32 * nc + 16 * wc + 8 * p + 4 * kh;
            const f32x4 ba = *(const f32x4*)(bias + j0), bb = *(const f32x4*)(bias + SSMW + j0);
            const u32x2 zr = *(const u32x2*)(UZ + grow * 4096 + SSMW + j0);
            const float z[4] = {bflo(zr.x), bfhi(zr.x), bflo(zr.y), bfhi(zr.y)}; float o[4];
#pragma unroll
            for (int e = 0; e < 4; ++e) o[e] = glu3(acc[8 * p + e] + ba[e], acc[8 * p + 4 + e] + bb[e], z[e]);
            u32x2 w; w.x = pk2(o[0], o[1]); w.y = pk2(o[2], o[3]); *(u32x2*)(V + grow * SSMW + j0) = w; }
    }
};
struct SkRes {
    float* X; bf16_t* XB; float* SSQ; const float* xin_s;
    __device__ __forceinline__ int brow_src(int nc, int brow) const { return nc * 64 + brow; }
    __device__ __forceinline__ void operator()(const f32x16& acc, int mr, int nc, int wr, int wc, int li, int kh, LAS unsigned char* lds) const {
        const size_t grow = (size_t)MP + mr * 128 + 32 * wr + li; const int col0 = nc * 64 + 32 * wc + 4 * kh;
        const bf16_t* xs = XB + grow * D + col0;
        u32x2 xo[4];
#pragma unroll
        for (int q = 0; q < 4; ++q) xo[q] = *(const u32x2*)(xs + 8 * q);
        float ss = 0.f;
#pragma unroll
        for (int q = 0; q < 4; ++q) { f32x4 o; o.x = bflo(xo[q].x) + acc[4 * q]; o.y = bfhi(xo[q].x) + acc[4 * q + 1]; o.z = bflo(xo[q].y) + acc[4 * q + 2]; o.w = bfhi(xo[q].y) + acc[4 * q + 3];
            u32x2 w; w.x = pk2(o.x, o.y); w.y = pk2(o.z, o.w); *(u32x2*)(XB + grow * D + col0 + 8 * q) = w;
            ss += (o.x * o.x + o.y * o.y) + (o.z * o.z + o.w * o.w); }
        ss += __shfl_xor(ss, 32);
        LAS float* part = (LAS float*)lds;
        if (wc == 1 && kh == 0) part[32 * wr + li] = ss;
        WG_BAR();
        if (wc == 0 && kh == 0) SSQ[grow * 16 + nc] = ss + part[32 * wr + li];
    }
};
template <class Epi>
__device__ __forceinline__ void gemm(LAS unsigned char* lds, const bf16_t* A, const bf16_t* Bt, int K, int nU, const Epi& E, int wg, int G, int lda_ = 0) {
    int tid_ = threadIdx.x; asm volatile("" : "+v"(tid_));
    const int tid = tid_, lane = tid & 63, w = __builtin_amdgcn_readfirstlane(tid >> 6), wr = w >> 1, wc = w & 1, li = lane & 31, kh = lane >> 5;
    const int ns = K >> 7, lda = lda_ ? lda_ : K;
    for (int it = wg; it < 4 * nU; it += G) {
        const int full_ = (nU & ~7) * 4, rem_ = nU & 7;
        int mr, nc;
        if (it < full_) { const int idx_ = it >> 3; mr = idx_ & 3; nc = (it & 7) + 8 * (idx_ >> 2); }
        else { const int r_ = it - full_; nc = (nU & ~7) + r_ % rem_; mr = r_ / rem_; }
        const bf16_t* ga = A + (size_t)(mr * 128 + (tid >> 4)) * lda + (tid & 15) * 8;
        const bf16_t* gb0 = Bt + (size_t)E.brow_src(nc, tid >> 4) * K + (tid & 15) * 8;
        const bf16_t* gb1 = Bt + (size_t)E.brow_src(nc, (tid >> 4) + 32) * K + (tid & 15) * 8;
        const int la = (tid >> 4) * PITCH + (tid & 15) * 16, lb = ABYTES + la;
        u32x4 raA[4], rbA[2], raB[4], rbB[2];
#define SK_LOAD(ra, rb, k0) do { _Pragma("unroll") for (int i_ = 0; i_ < 4; ++i_) ra[i_] = *(const u32x4*)(ga + (size_t)(32 * i_) * lda + (k0)); rb[0] = *(const u32x4*)(gb0 + (k0)); rb[1] = *(const u32x4*)(gb1 + (k0)); } while (0)
#define SK_STORE(ra, rb, buf) do { LAS unsigned char* sb_ = lds + (buf) * STG; _Pragma("unroll") for (int i_ = 0; i_ < 4; ++i_) *(LAS u32x4*)(sb_ + la + 32 * i_ * PITCH) = ra[i_]; \
        *(LAS u32x4*)(sb_ + lb) = rb[0]; *(LAS u32x4*)(sb_ + lb + 32 * PITCH) = rb[1]; } while (0)
#define SK_COMPUTE(s) do { const LAS unsigned char* sa_ = lds + ((s) & 1) * STG + (32 * wr + li) * PITCH + kh * 16; const LAS unsigned char* sbb_ = lds + ((s) & 1) * STG + ABYTES + (32 * wc + li) * PITCH + kh * 16; \
        _Pragma("unroll") for (int ks = 0; ks < 8; ++ks) { const bf16x8 bf = *(const LAS bf16x8*)(sbb_ + ks * 32); const bf16x8 af = *(const LAS bf16x8*)(sa_ + ks * 32); \
            acc = __builtin_amdgcn_mfma_f32_32x32x16_bf16(bf, af, acc, 0, 0, 0); } } while (0)
        f32x16 acc;
#pragma unroll
        for (int r = 0; r < 16; ++r) acc[r] = 0.f;
        SK_LOAD(raA, rbA, 0); SK_LOAD(raB, rbB, 128);
        SK_STORE(raA, rbA, 0); WG_BAR();
        for (int s = 0; s < ns; s += 2) {
            if (s + 2 < ns) SK_LOAD(raA, rbA, (s + 2) * 128);
            __builtin_amdgcn_sched_barrier(0);
            SK_COMPUTE(s);
            if (s + 1 < ns) SK_STORE(raB, rbB, 1);
            WG_BAR();
            if (s + 1 < ns) {
                if (s + 3 < ns) SK_LOAD(raB, rbB, (s + 3) * 128);
                __builtin_amdgcn_sched_barrier(0);
                SK_COMPUTE(s + 1);
                if (s + 2 < ns) SK_STORE(raA, rbA, 0);
                WG_BAR();
            }
        }
#undef SK_LOAD
#undef SK_STORE
#undef SK_COMPUTE
        E(acc, mr, nc, wr, wc, li, kh, lds);
        WG_BAR();
    }
}
}

#define XB_TMO      128
#define XB_XCNT(j)  (256  + 64 * (j))
#define XB_XSUB(j)  (1280 + 64 * (j))
#define XB_XGEN(j)  (2304 + 64 * (j))
#define XB_TOP      3328
#define XB_TOPGEN   3392
#define XCD_BAR_WORDS 3456
#define XB_SPIN_CAP (1u << 18)
__device__ __forceinline__ unsigned xb_ld(unsigned* p)              { return __hip_atomic_load(p, __ATOMIC_RELAXED, __HIP_MEMORY_SCOPE_AGENT); }
__device__ __forceinline__ unsigned xb_add(unsigned* p, unsigned v) { return __hip_atomic_fetch_add(p, v, __ATOMIC_RELAXED, __HIP_MEMORY_SCOPE_AGENT); }
__device__ __forceinline__ unsigned xb_xcc_id() { return (unsigned)__builtin_amdgcn_s_getreg((3 << 11) | 20) & 0xFu; }
#define XB_SPIN(cond, bar) do { unsigned _sp = 0; while (cond) { __builtin_amdgcn_s_sleep(1); \
    if ((++_sp & 255u) == 0u) { if (xb_ld(&(bar)[XB_TMO])) break; if (_sp > XB_SPIN_CAP) { atomicAdd(&(bar)[XB_TMO], 1u); break; } } } } while (0)
struct XcdBarrier { unsigned* bar; unsigned x; volatile LAS unsigned* st; };
__device__ __forceinline__ XcdBarrier xcd_barrier_post(unsigned* bar, volatile LAS unsigned* st) {
    XcdBarrier b; b.bar = bar; b.x = xb_xcc_id(); b.st = st;
    if (threadIdx.x == 0) (void)xb_add(&bar[XB_XCNT(b.x)], 1u);
    return b;
}
__device__ __forceinline__ void xcd_barrier_complete(unsigned* bar, unsigned x, unsigned& nloc, unsigned& nx) {
    const unsigned G = gridDim.x * gridDim.y * gridDim.z;
    unsigned sum, cnt, mine, sp = 0u;
    for (;;) {
        sum = 0u; cnt = 0u; mine = 0u;
#pragma unroll
        for (unsigned j = 0; j < 16; ++j) { const unsigned c = xb_ld(&bar[XB_XCNT(j)]); sum += c; cnt += (c > 0u) ? 1u : 0u; mine = (j == x) ? c : mine; }
        if (sum == G) break;
        __builtin_amdgcn_s_sleep(1);
        if ((++sp & 255u) == 0u) { if (xb_ld(&bar[XB_TMO])) break; if (sp > XB_SPIN_CAP) { atomicAdd(&bar[XB_TMO], 1u); break; } }
    }
    nloc = mine > 0u ? mine : 1u; nx = cnt > 0u ? cnt : 1u;
}
__device__ __forceinline__ void xcd_barrier(const XcdBarrier& b) {
    asm volatile("s_waitcnt vmcnt(0)" ::: "memory");
    __syncthreads();
    if (threadIdx.x == 0) {
        unsigned* bar = b.bar;
        __builtin_amdgcn_s_waitcnt(0);
        unsigned nloc = b.st[0], nx = b.st[1];
        if (nloc == 0u) { xcd_barrier_complete(bar, b.x, nloc, nx); b.st[0] = nloc; b.st[1] = nx; }
        const unsigned old = xb_add(&bar[XB_XSUB(b.x)], 1u);
        const unsigned gen = old / nloc;
        if (old + 1u == (gen + 1u) * nloc) {
            __builtin_amdgcn_fence(__ATOMIC_RELEASE, "agent");
            asm volatile("s_waitcnt vmcnt(0)" ::: "memory");
            const unsigned og = xb_add(&bar[XB_TOP], 1u);
            if (og + 1u < (gen + 1u) * nx) XB_SPIN(xb_ld(&bar[XB_TOP]) < (gen + 1u) * nx, bar);
        } else {
            XB_SPIN(xb_ld(&bar[XB_TOP]) < (gen + 1u) * nx, bar);
        }
        __builtin_amdgcn_fence(__ATOMIC_ACQUIRE, "agent");
        asm volatile("s_waitcnt vmcnt(0)" ::: "memory");
    }
    __syncthreads();
}

struct Args {
    const float* x_prompt; const float* x_sample; const float* cache_latent; const float* cache_krope; const int* page_table;
    const float* state_re; const float* state_im;
    const float* norm_a; const float* w_in_a; const float* a_re; const float* a_im; const float* log_dt; const float* b_re; const float* b_im;
    const float* c_re; const float* c_im; const float* d_skip; const float* w_glu; const float* b_glu; const float* w_out_a;
    const float* norm_kv; const float* w_dkv; const float* norm_latent; const float* w_uk; const float* w_uv;
    const float* norm_b; const float* w_in_b; const float* norm_q; const float* w_uq; const float* w_out_b; const float* norm_f;
    float* out; unsigned char* ws; int ph_lo, ph_hi;
};

__device__ __forceinline__ void tr_item(const float* __restrict__ W, int ldw, const float* __restrict__ gain, bf16_t* WT, int K, int drow0, int k0, int n0, LAS float* scr, int lane) {
    {
        f32x4 v[8]; float gk[8];
#pragma unroll
        for (int i = 0; i < 8; ++i) { const int kk = 8 * i + (lane >> 3); v[i] = *(const f32x4*)(W + (size_t)(k0 + kk) * ldw + n0 + 4 * (lane & 7)); gk[i] = gain ? gain[k0 + kk] : 1.0f; }
#pragma unroll
        for (int i = 0; i < 8; ++i) { const int kk = 8 * i + (lane >> 3); LAS float* d = scr + kk * 33 + 4 * (lane & 7);
            d[0] = v[i].x * gk[i]; d[1] = v[i].y * gk[i]; d[2] = v[i].z * gk[i]; d[3] = v[i].w * gk[i]; }
    }
    LDS_WAIT(); asm volatile("" ::: "memory");
    const int c = lane & 7;
#pragma unroll
    for (int j = 0; j < 4; ++j) { const int n = (lane >> 3) + 8 * j; const LAS float* s = scr + (8 * c) * 33 + n;
        u32x4 o; o.x = pk2(s[0 * 33], s[1 * 33]); o.y = pk2(s[2 * 33], s[3 * 33]); o.z = pk2(s[4 * 33], s[5 * 33]); o.w = pk2(s[6 * 33], s[7 * 33]);
        *(u32x4*)(WT + (size_t)(drow0 + n) * K + k0 + 8 * c) = o; }
    LDS_WAIT(); asm volatile("" ::: "memory");
}
__device__ __forceinline__ bool tr_job(int& r, const float* W, int K, int N, int ldw, const float* gain, bf16_t* WT, int drow_base, bool glu, LAS float* scr, int lane) {
    const int nb = N / 32, items = (K / 64) * nb;
    if (r >= items) { r -= items; return false; }
    const int kb = r / nb, nbk = r % nb, n0 = 32 * nbk;
    int drow0 = drow_base + n0;
    if (glu) { const int bj = n0 >> 11, j = n0 & 2047; drow0 = 256 * (j >> 7) + 128 * bj + (j & 127); }
    tr_item(W, ldw, gain, WT, K, drow0, 64 * kb, n0, scr, lane);
    return true;
}
template <int SET>
__device__ __forceinline__ void convert_weights(const Args& a, LAS unsigned char* lds, int gwi, int ngwi, int wave, int lane) {
    unsigned char* ws = a.ws;
    LAS float* scr = (LAS float*)(lds + wave * 16384);
    bf16_t* Win = (bf16_t*)(ws + WS_WIN); bf16_t* Wglu = (bf16_t*)(ws + WS_WGLU); bf16_t* Wout = (bf16_t*)(ws + WS_WOUT); bf16_t* Winb = (bf16_t*)(ws + WS_WINB);
    bf16_t* Wuq = (bf16_t*)(ws + WS_WUQ); bf16_t* Wuk = (bf16_t*)(ws + WS_WUK); bf16_t* Wuv = (bf16_t*)(ws + WS_WUV); bf16_t* Woutb = (bf16_t*)(ws + WS_WOUTB);
    constexpr int I_IN = 16 * 128, I_GLU = 32 * 128, I_OUT = 32 * 32, I_INB = 16 * 44, I_DKV = 16 * 10, I_UQ = 6 * 48, I_UK = 4 * 32, I_OUTB = 16 * 32;
    constexpr int NITEMS = SET == 0 ? I_IN : SET == 1 ? I_GLU + I_OUT : SET == 2 ? I_IN + I_GLU + I_OUT : 2 * (I_INB + I_UQ + I_OUTB) + I_DKV + 2 * I_UK;
    for (int it = gwi; it < NITEMS; it += ngwi) {
        int r = it; bool done = false;
        if (SET == 0) { done = tr_job(r, a.w_in_a, 1024, 4096, 4096, a.norm_a, Win, 0, false, scr, lane); }
        if (SET == 1) {
            if (!done) done = tr_job(r, a.w_glu, 2048, 4096, 4096, nullptr, Wglu, 0, true, scr, lane);
            if (!done) done = tr_job(r, a.w_out_a, 2048, 1024, 1024, nullptr, Wout, 0, false, scr, lane);
        }
        if (SET == 2) {
            if (!done) done = tr_job(r, a.w_in_a + (size_t)1024 * 4096, 1024, 4096, 4096, a.norm_a + 1024, Win + (size_t)4096 * 1024, 0, false, scr, lane);
            if (!done) done = tr_job(r, a.w_glu + (size_t)2048 * 4096, 2048, 4096, 4096, nullptr, Wglu + (size_t)4096 * 2048, 0, true, scr, lane);
            if (!done) done = tr_job(r, a.w_out_a + (size_t)2048 * 1024, 2048, 1024, 1024, nullptr, Wout + (size_t)1024 * 2048, 0, false, scr, lane);
        }
        if (SET == 3) {
#pragma unroll
            for (int i = 0; i < 2; ++i) {
                if (!done) done = tr_job(r, a.w_in_b + (size_t)i * 1024 * 1408, 1024, 1408, 1408, a.norm_b + i * 1024, Winb + (size_t)i * 1792 * 1024, 0, false, scr, lane);
                if (!done) done = tr_job(r, a.w_uq + (size_t)i * 384 * 1536, 384, 1536, 1536, a.norm_q + i * 384, Wuq + (size_t)i * 1536 * 384, 0, false, scr, lane);
                if (!done) done = tr_job(r, a.w_out_b + (size_t)i * 1024 * 1024, 1024, 1024, 1024, nullptr, Woutb + (size_t)i * 1024 * 1024, 0, false, scr, lane);
            }
            if (!done) done = tr_job(r, a.w_dkv, 1024, 320, 320, a.norm_kv, Winb, 1408, false, scr, lane);
            if (!done) done = tr_job(r, a.w_uk, 256, 1024, 1024, nullptr, Wuk, 0, false, scr, lane);
            if (!done) done = tr_job(r, a.w_uv, 256, 1024, 1024, nullptr, Wuv, 0, false, scr, lane);
        }
    }
}
template <int NR> __device__ __forceinline__ void xprep_rows(const Args& a, int m0, int lane) {
    bf16_t* XB = (bf16_t*)(a.ws + WS_XB); float* SSQ = (float*)(a.ws + WS_SSQ);
    f32x4 v[NR][4];
#pragma unroll
    for (int k = 0; k < NR; ++k) { const int m = m0 + k; const float* src = m < MP ? a.x_prompt + (size_t)m * D : a.x_sample + (size_t)(m - MP) * D;
#pragma unroll
        for (int j = 0; j < 4; ++j) v[k][j] = *(const f32x4*)(src + 4 * lane + 256 * j); }
#pragma unroll
    for (int k = 0; k < NR; ++k) { const int m = m0 + k; float ss = 0.f;
#pragma unroll
        for (int j = 0; j < 4; ++j) ss += (v[k][j].x * v[k][j].x + v[k][j].y * v[k][j].y) + (v[k][j].z * v[k][j].z + v[k][j].w * v[k][j].w);
        ss = wave_sum(ss);
#pragma unroll
        for (int j = 0; j < 4; ++j) { u32x2 o; o.x = pk2(v[k][j].x, v[k][j].y); o.y = pk2(v[k][j].z, v[k][j].w); *(u32x2*)(XB + (size_t)m * D + 4 * lane + 256 * j) = o; }
        if (lane < 16) SSQ[(size_t)m * 16 + lane] = lane == 0 ? ss : 0.f; }
}
__device__ __forceinline__ void prologue_phase(const Args& a, LAS unsigned char* lds, int gw, int ngw, int wave, int lane, int gtid, int gthreads) {
    unsigned char* ws = a.ws;
    bf16_t* Winb = (bf16_t*)(ws + WS_WINB);
    convert_weights<0>(a, lds, gw, ngw, wave, lane); convert_weights<1>(a, lds, gw, ngw, wave, lane); convert_weights<2>(a, lds, gw, ngw, wave, lane); convert_weights<3>(a, lds, gw, ngw, wave, lane);
    { u32x4 z = {0u, 0u, 0u, 0u};
      for (int i = gtid; i < 64 * 1024 / 8; i += gthreads) *(u32x4*)(Winb + (size_t)1728 * 1024 + (size_t)i * 8) = z;
      for (int i = gtid; i < 128 * 1024 / 8; i += gthreads) *(u32x4*)(Winb + (size_t)1792 * 1024 + (size_t)1408 * 1024 + (size_t)i * 8) = z; }
    { bf16_t* Wukb = (bf16_t*)(ws + WS_WUKB);
      for (int i = gtid; i < 256 * 1024 / 4; i += gthreads) { const f32x4 v = *(const f32x4*)(a.w_uk + (size_t)i * 4); u32x2 o; o.x = pk2(v[0], v[1]); o.y = pk2(v[2], v[3]); *(u32x2*)(Wukb + (size_t)i * 4) = o; } }
    { float* rc = (float*)(ws + WS_ROPE); float* rs = rc + 2052 * 32;
      for (int i = gtid; i < 2052 * 32; i += gthreads) { const int idx = i >> 5, f = i & 31; const int pos = idx < 2048 ? idx : 8192 + (idx - 2048);
          const float inv = (float)exp2(-(double)f * (13.287712379549449 / 32.0));
          const float ang = (float)pos * inv;
          const double rev = (double)ang * 0.15915494309189535; const float fr = (float)(rev - rint(rev));
          rc[i] = __builtin_amdgcn_cosf(fr); rs[i] = __builtin_amdgcn_sinf(fr); } }
    { f32x4* scp = (f32x4*)(ws + WS_SCP);
      for (int i = gtid; i < 2 * NG * ST; i += gthreads) { const int lg = i >> 6;
          const double dt = exp((double)a.log_dt[lg]); const double lre = (double)a.a_re[i], lim = (double)a.a_im[i];
          const double mag = exp(lre * dt); const double lbr = mag * cos(lim * dt), lbi = mag * sin(lim * dt);
          const double den = lre * lre + lim * lim, nr = lbr - 1.0;
          f32x4 o; o.x = (float)lbr; o.y = (float)lbi; o.z = (float)((nr * lre + lbi * lim) / den); o.w = (float)((lbi * lre - nr * lim) / den); scp[i] = o; } }
    for (int m0 = gw * 4; m0 < MP; m0 += ngw * 4) xprep_rows<4>(a, m0, lane);
    for (int m = MP + gw; m < M; m += ngw) xprep_rows<1>(a, m, lane);
}

constexpr int SC_ROW = 272, SC_BUF = 8 * 16 * SC_ROW;
constexpr int SC_UT = 2 * SC_BUF, SC_UP = 144;
__device__ __forceinline__ void scan_phase(const Args& a, int layer, LAS unsigned char* lds, int wg, int nwg) {
    int tid_ = threadIdx.x; asm volatile("" : "+v"(tid_));
    const int tid = tid_, lane = tid & 63, w = __builtin_amdgcn_readfirstlane(tid >> 6), gl = w >> 1, ph = w & 1, pl = lane & 31, hf = lane >> 5;
    const bf16_t* UZ = (const bf16_t*)(a.ws + WS_UZ); bf16_t* YG = (bf16_t*)(a.ws + WS_YG);
    const float* A_re = a.a_re + (size_t)layer * NG * ST; const float* A_im = a.a_im + (size_t)layer * NG * ST; const float* LDT = a.log_dt + (size_t)layer * NG;
    const float* B_re = a.b_re + (size_t)layer * NG * ST * 16; const float* B_im = a.b_im + (size_t)layer * NG * ST * 16;
    const float* C_re = a.c_re + (size_t)layer * NG * 16 * ST; const float* C_im = a.c_im + (size_t)layer * NG * 16 * ST;
    const float* DSK = a.d_skip + (size_t)layer * SSMW;
    const int ai = lane & 31, a_hf = (ai >> 2) & 1, a_t = 4 * (ai >> 3) + (ai & 3), a_kh = lane >> 5;
    const int ot = lane & 15, oq = lane >> 4;
    const int ld_t = tid >> 3, ld_ch = tid & 7;
    const LAS unsigned char* ut_a = lds + SC_UT + (a_hf * 128 + a_t) * SC_UP + (gl * 16 + 8 * a_kh) * 2;
    const LAS unsigned char* ut_o = lds + SC_UT + (ph * 128 + ot) * SC_UP + (gl * 16 + 4 * oq) * 2;
    for (int u = wg; u < 512; u += nwg) {
        const bool samp = u >= 256; const int uu = samp ? u - 256 : u;
        const int gq = uu & 31, bc = uu >> 5;
        const int g = gq * 4 + gl, p = 32 * ph + pl;
        float lr, li; bf16x8 bfr, bfi, cfr[4]; f32x4 dsk;
        {
            const f32x4 scp = *((const f32x4*)(a.ws + WS_SCP) + ((size_t)layer * NG + g) * ST + p);
            const float fre = scp.z, fim = scp.w;
            lr = scp.x; li = scp.y;
            const f32x4* br4 = (const f32x4*)(B_re + ((size_t)g * ST + p) * 16 + 8 * hf); const f32x4* bi4 = (const f32x4*)(B_im + ((size_t)g * ST + p) * 16 + 8 * hf);
            const f32x4 r0 = br4[0], r1 = br4[1], i0 = bi4[0], i1 = bi4[1];
            float re[8] = {r0.x, r0.y, r0.z, r0.w, r1.x, r1.y, r1.z, r1.w}, im[8] = {i0.x, i0.y, i0.z, i0.w, i1.x, i1.y, i1.z, i1.w};
            unsigned pr[4], pi[4];
#pragma unroll
            for (int j = 0; j < 4; ++j) { pr[j] = pk2(fre * re[2 * j] - fim * im[2 * j], fre * re[2 * j + 1] - fim * im[2 * j + 1]); pi[j] = pk2(fre * im[2 * j] + fim * re[2 * j], fre * im[2 * j + 1] + fim * re[2 * j + 1]); }
            u32x4 t; t.x = pr[0]; t.y = pr[1]; t.z = pr[2]; t.w = pr[3]; bfr = __builtin_bit_cast(bf16x8, t); t.x = pi[0]; t.y = pi[1]; t.z = pi[2]; t.w = pi[3]; bfi = __builtin_bit_cast(bf16x8, t);
#pragma unroll
            for (int s = 0; s < 4; ++s) { const f32x4 cr = *(const f32x4*)(C_re + ((size_t)g * 16 + ot) * ST + 16 * s + 4 * oq); const f32x4 ci = *(const f32x4*)(C_im + ((size_t)g * 16 + ot) * ST + 16 * s + 4 * oq);
                u32x4 c4; c4.x = pk2(cr.x, -ci.x); c4.y = pk2(cr.y, -ci.y); c4.z = pk2(cr.z, -ci.z); c4.w = pk2(cr.w, -ci.w); cfr[s] = __builtin_bit_cast(bf16x8, c4); }
            dsk = *(const f32x4*)(DSK + g * 16 + 4 * oq);
            asm volatile("" :: "v"(dsk));
        }
        const int nit = samp ? 8 : 1, L = samp ? 4 : SEQ, nchunk = samp ? 1 : SEQ / 128;
        u32x4 pre[4]; float xr_n = 0.f, xi_n = 0.f;
        for (int it = 0; it < nit; ++it) {
            const int bp = samp ? bc * 8 + it : bc;
            const int b_scan = 2 * bp + hf, b_o = 2 * bp + ph;
            const size_t rb0 = samp ? (size_t)MP + (size_t)(2 * bp) * 4 : (size_t)(2 * bp) * SEQ;
            const size_t rb_o = rb0 + (size_t)ph * L;
            float xr = 0.f, xi = 0.f;
            const bf16_t* gsrc = UZ + gq * 64 + ld_ch * 8;
#define SC_LOADB(rb, c0) do { if (!samp) { _Pragma("unroll") for (int i_ = 0; i_ < 4; ++i_) pre[i_] = *(const u32x4*)(gsrc + ((rb) + (size_t)(i_ >> 1) * L + (c0) + ld_t + 64 * (i_ & 1)) * 4096); } \
            else { _Pragma("unroll") for (int i_ = 0; i_ < 4; ++i_) { const int t_ = (c0) + ld_t + 64 * (i_ & 1); const int tc_ = t_ < L ? t_ : L - 1; \
                const u32x4 v_ = *(const u32x4*)(gsrc + ((rb) + (size_t)(i_ >> 1) * L + tc_) * 4096);         \
                pre[i_] = t_ < L ? v_ : (u32x4){0u, 0u, 0u, 0u}; } } } while (0)
#define SC_LOAD(c0) SC_LOADB(rb0, c0)
            if (samp && it > 0) { xr = xr_n; xi = xi_n; }
            else { if (samp) { const size_t so = (((size_t)layer * 128 + b_scan) * NG + g) * ST + p; xr = a.state_re[so]; xi = a.state_im[so]; }
                   SC_LOAD(0); }
            const int nblk = samp ? 1 : SEQ / 16;
            LAS unsigned* wp0 = (LAS unsigned*)(lds + ((gl * 2 + hf) * 16) * SC_ROW + p * 4);
            const float nli = -li;
            const LAS unsigned char* rp0 = lds + ((gl * 2 + ph) * 16 + ot) * SC_ROW + oq * 16;
            u32x2 us_prev = {0u, 0u};
#define SC_OUT(m, check) do { const LAS unsigned char* rp_ = rp0 + ((m) & 1) * SC_BUF; f32x4 yv_ = {0.f, 0.f, 0.f, 0.f}; \
                _Pragma("unroll") for (int s_ = 0; s_ < 4; ++s_) { const bf16x8 xb_ = *(const LAS bf16x8*)(rp_ + s_ * 64); yv_ = __builtin_amdgcn_mfma_f32_16x16x32_bf16(cfr[s_], xb_, yv_, 0, 0, 0); } \
                if (!(check) || ((m) * 16 + ot < L)) { \
                    const float y0_ = gelu_tanh(yv_[0] + dsk.x * bflo(us_prev.x)), y1_ = gelu_tanh(yv_[1] + dsk.y * bfhi(us_prev.x)), y2_ = gelu_tanh(yv_[2] + dsk.z * bflo(us_prev.y)), y3_ = gelu_tanh(yv_[3] + dsk.w * bfhi(us_prev.y)); \
                    u32x2 o_; o_.x = pk2(y0_, y1_); o_.y = pk2(y2_, y3_); *(u32x2*)(YG + (rb_o + (m) * 16 + ot) * SSMW + g * 16 + 4 * oq) = o_; } } while (0)
            {
#pragma unroll
                for (int i_ = 0; i_ < 4; ++i_) *(LAS u32x4*)(lds + SC_UT + ((i_ >> 1) * 128 + ld_t + 64 * (i_ & 1)) * SC_UP + ld_ch * 16) = pre[i_];
                WG_BAR();
                if (8 < nblk) SC_LOAD(128);
                if (samp && it + 1 < nit) {
                    const int bpn = bc * 8 + it + 1; const size_t rbn = (size_t)MP + (size_t)(2 * bpn) * 4;
                    SC_LOADB(rbn, 0);
                    const size_t son = (((size_t)layer * 128 + 2 * bpn + hf) * NG + g) * ST + p; xr_n = a.state_re[son]; xi_n = a.state_im[son]; }
                const bf16x8 acur = *(const LAS bf16x8*)(ut_a);
                us_prev = *(const LAS u32x2*)(ut_o);
                f32x16 bur, bui;
#pragma unroll
                for (int r = 0; r < 16; ++r) { bur[r] = 0.f; bui[r] = 0.f; }
                bur = __builtin_amdgcn_mfma_f32_32x32x16_bf16(acur, bfr, bur, 0, 0, 0);
                bui = __builtin_amdgcn_mfma_f32_32x32x16_bf16(acur, bfi, bui, 0, 0, 0);
                const int nst = L < 16 ? L : 16;
#pragma unroll
                for (int r = 0; r < 16; ++r) {
                    if (r < nst) {
                        const float t1 = fmaf(lr, xr, bur[r]), t2 = fmaf(lr, xi, bui[r]);
                        const float nxr = fmaf(-li, xi, t1), nxi = fmaf(li, xr, t2);
                        xr = nxr; xi = nxi;
                        wp0[r * (SC_ROW / 4)] = pk2(xr, xi);
                    }
                }
                WG_BAR();
            }
            for (int n = 1; n < nblk; ++n) {
                if ((n & 7) == 0) {
#pragma unroll
                    for (int i_ = 0; i_ < 4; ++i_) *(LAS u32x4*)(lds + SC_UT + ((i_ >> 1) * 128 + ld_t + 64 * (i_ & 1)) * SC_UP + ld_ch * 16) = pre[i_];
                    WG_BAR();
                    if (n + 8 < nblk) SC_LOAD((n + 8) * 16);
                }
                const int blk = n & 7;
                const bf16x8 acur = *(const LAS bf16x8*)(ut_a + blk * 16 * SC_UP);
                const u32x2 us_cur = *(const LAS u32x2*)(ut_o + blk * 16 * SC_UP);
                f32x16 bur, bui;
#pragma unroll
                for (int r = 0; r < 16; ++r) { bur[r] = 0.f; bui[r] = 0.f; }
                bur = __builtin_amdgcn_mfma_f32_32x32x16_bf16(acur, bfr, bur, 0, 0, 0);
                bui = __builtin_amdgcn_mfma_f32_32x32x16_bf16(acur, bfi, bui, 0, 0, 0);
                const LAS unsigned char* rpo = rp0 + ((n - 1) & 1) * SC_BUF; f32x4 yv = {0.f, 0.f, 0.f, 0.f};
#pragma unroll
                for (int s_ = 0; s_ < 4; ++s_) { const bf16x8 xb_ = *(const LAS bf16x8*)(rpo + s_ * 64); yv = __builtin_amdgcn_mfma_f32_16x16x32_bf16(cfr[s_], xb_, yv, 0, 0, 0); }
                LAS unsigned* wp = wp0 + (n & 1) * (SC_BUF / 4);
                float yo[4];
#pragma unroll
                for (int r = 0; r < 16; ++r) {
                    const float t1 = fmaf(lr, xr, bur[r]), t2 = fmaf(lr, xi, bui[r]);
                    const float nxr = fmaf(nli, xi, t1), nxi = fmaf(li, xr, t2);
                    xr = nxr; xi = nxi;
                    wp[r * (SC_ROW / 4)] = pk2(xr, xi);
                    if (r == 3)  yo[0] = gelu_tanh(yv[0] + dsk.x * bflo(us_prev.x));
                    if (r == 6)  yo[1] = gelu_tanh(yv[1] + dsk.y * bfhi(us_prev.x));
                    if (r == 9)  yo[2] = gelu_tanh(yv[2] + dsk.z * bflo(us_prev.y));
                    if (r == 12) yo[3] = gelu_tanh(yv[3] + dsk.w * bfhi(us_prev.y));
                }
                { u32x2 o_; o_.x = pk2(yo[0], yo[1]); o_.y = pk2(yo[2], yo[3]); *(u32x2*)(YG + (rb_o + (n - 1) * 16 + ot) * SSMW + g * 16 + 4 * oq) = o_; }
                WG_BAR();
                us_prev = us_cur;
            }
            SC_OUT(nblk - 1, true);
#undef SC_OUT
#undef SC_LOAD
#undef SC_LOADB
            { const size_t so = samp ? (((size_t)layer * 128 + b_scan) * NG + g) * ST + p : (((size_t)layer * 16 + b_scan) * NG + g) * ST + p;
              float* ore = a.out + (samp ? O_HSR : O_HPR); float* oim = a.out + (samp ? O_HSI : O_HPI);
              ore[so] = xr; oim[so] = xi; }
        }
        WG_BAR();
    }
}

template <int NR> __device__ __forceinline__ void t1_rows(const Args& a, int j, int m0, int lane) {
    const bf16_t* C1 = (const bf16_t*)(a.ws + WS_C1); bf16_t* CQN = (bf16_t*)(a.ws + WS_CQN); bf16_t* LATB = (bf16_t*)(a.ws + WS_LATB); bf16_t* KRB = (bf16_t*)(a.ws + WS_KRB);
    const float* rc = (const float*)(a.ws + WS_ROPE); const float* rs = rc + 2052 * 32;
    {
        u32x2 rawl[NR]; unsigned short k1[NR], k2[NR];
#pragma unroll
        for (int k = 0; k < NR; ++k) { const bf16_t* c1 = C1 + (size_t)(m0 + k) * LDC1;
            if (j == 0) { rawl[k] = *(const u32x2*)(c1 + 1408 + 4 * lane); k1[k] = c1[1408 + 256 + (lane & 31)]; k2[k] = c1[1408 + 256 + 32 + (lane & 31)]; } }
#pragma unroll
        for (int k = 0; k < NR; ++k) { const int m = m0 + k;
            if (j == 0) {
                const float l0 = bflo(rawl[k].x), l1 = bfhi(rawl[k].x), l2 = bflo(rawl[k].y), l3 = bfhi(rawl[k].y);
                const float s2 = wave_sum((l0 * l0 + l1 * l1) + (l2 * l2 + l3 * l3));
                const float rl = __builtin_amdgcn_rsqf(s2 * (1.0f / KVL) + EPS);
                const f32x4 gl4 = *(const f32x4*)(a.norm_latent + 4 * lane);
                f32x4 o; o.x = l0 * rl * gl4.x; o.y = l1 * rl * gl4.y; o.z = l2 * rl * gl4.z; o.w = l3 * rl * gl4.w;
                float* olat = m < MP ? a.out + O_LATP + (size_t)m * KVL : a.out + O_LATS + (size_t)(m - MP) * KVL;
                *(f32x4*)(olat + 4 * lane) = o;
                u32x2 ob; ob.x = pk2(o.x, o.y); ob.y = pk2(o.z, o.w); *(u32x2*)(LATB + (size_t)m * KVL + 4 * lane) = ob;
                if (lane < 32) {
                    const float x1 = bf1(k1[k]), x2 = bf1(k2[k]);
                    const int idx = m < MP ? (m & (SEQ - 1)) : 2048 + ((m - MP) & 3);
                    const float c = rc[idx * 32 + lane], s = rs[idx * 32 + lane];
                    const float o1 = x1 * c - x2 * s, o2 = x1 * s + x2 * c;
                    float* okr = m < MP ? a.out + O_KRP + (size_t)m * ROPE : a.out + O_KRS + (size_t)(m - MP) * ROPE;
                    okr[lane] = o1; okr[32 + lane] = o2;
                    KRB[(size_t)m * ROPE + lane] = f2bf(o1); KRB[(size_t)m * ROPE + 32 + lane] = f2bf(o2);
                }
            }
        }
    }
}
__device__ __forceinline__ void t1_phase(const Args& a, int j, int gw, int ngw, int lane) {
    for (int m0 = gw * 4; m0 < MP; m0 += ngw * 4) t1_rows<4>(a, j, m0, lane);
    for (int m = MP + gw; m < M; m += ngw) t1_rows<1>(a, j, m, lane);
}
template <int NR> __device__ __forceinline__ void final_rows(const Args& a, const f32x4 (&g)[4], int m0, int lane) {
    const bf16_t* XB = (const bf16_t*)(a.ws + WS_XB); const float* SSQ = (const float*)(a.ws + WS_SSQ);
    u32x4 v[NR][2]; float sq[NR];
#pragma unroll
    for (int k = 0; k < NR; ++k) { sq[k] = SSQ[(size_t)(m0 + k) * 16 + (lane & 15)];
#pragma unroll
        for (int j = 0; j < 2; ++j) v[k][j] = *(const u32x4*)(XB + (size_t)(m0 + k) * D + 8 * lane + 512 * j); }
#pragma unroll
    for (int k = 0; k < NR; ++k) { const int m = m0 + k;
        const float r = __builtin_amdgcn_rsqf(wave_sum(lane < 16 ? sq[k] : 0.f) * (1.0f / D) + EPS);
        float* o = m < MP ? a.out + O_YP + (size_t)m * D : a.out + O_YS + (size_t)(m - MP) * D;
#pragma unroll
        for (int j = 0; j < 2; ++j) { const u32x4 x = v[k][j]; f32x4 y0, y1;
            y0.x = bflo(x.x) * r * g[2 * j].x; y0.y = bfhi(x.x) * r * g[2 * j].y; y0.z = bflo(x.y) * r * g[2 * j].z; y0.w = bfhi(x.y) * r * g[2 * j].w;
            y1.x = bflo(x.z) * r * g[2 * j + 1].x; y1.y = bfhi(x.z) * r * g[2 * j + 1].y; y1.z = bflo(x.w) * r * g[2 * j + 1].z; y1.w = bfhi(x.w) * r * g[2 * j + 1].w;
            *(f32x4*)(o + 8 * lane + 512 * j) = y0; *(f32x4*)(o + 8 * lane + 512 * j + 4) = y1; } }
}
__device__ __forceinline__ void final_phase(const Args& a, int gw, int ngw, int lane) {
    f32x4 g[4];
#pragma unroll
    for (int j = 0; j < 4; ++j) g[j] = *(const f32x4*)(a.norm_f + 8 * lane + 512 * (j >> 1) + 4 * (j & 1));
    for (int m0 = gw * 4; m0 < MP; m0 += ngw * 4) final_rows<4>(a, g, m0, lane);
    for (int m = MP + gw; m < M; m += ngw) final_rows<1>(a, g, m, lane);
}

template <int OFF> __device__ __forceinline__ void ds_read128(bf16x8& d, unsigned addr) { asm volatile("ds_read_b128 %0, %1 offset:%2" : "=v"(d) : "v"(addr), "n"(OFF)); }
template <int N> __device__ __forceinline__ void lgkm_wait_dep(bf16x8& x) { asm volatile("s_waitcnt lgkmcnt(%1)" : "+v"(x) : "n"(N)); }
constexpr int AT_KP = 400, AT_VP = 144, AT_KB = 64 * AT_KP, AT_VB = 128 * AT_VP, AT_STAGE = AT_KB + AT_VB;
__device__ __forceinline__ int pi32(int i) { return (i & 19) | ((i & 4) << 1) | ((i & 8) >> 1); }
constexpr int AT_RING = 6;
template <int I> __device__ __forceinline__ void at_qk_steps(bf16x8 (&ring)[AT_RING], unsigned kaddr, const bf16x8 (&qf)[12], f32x16 (&sacc)[2]) {
    if constexpr (I < 24) {
        lgkm_wait_dep<(23 - I < AT_RING - 1 ? 23 - I : AT_RING - 1)>(ring[I % AT_RING]);
        sacc[I / 12] = __builtin_amdgcn_mfma_f32_32x32x16_bf16(ring[I % AT_RING], qf[I % 12], sacc[I / 12], 0, 0, 0);
        if constexpr (I + AT_RING < 24) ds_read128<((I + AT_RING) / 12) * 32 * AT_KP + ((I + AT_RING) % 12) * 32>(ring[I % AT_RING], kaddr);
        at_qk_steps<I + 1>(ring, kaddr, qf, sacc);
    }
}
template <int I> __device__ __forceinline__ void at_pv_steps(bf16x8 (&ring)[AT_RING], unsigned vaddr, const bf16x8 (&pf)[4], f32x16 (&oacc)[4]) {
    if constexpr (I < 16) {
        lgkm_wait_dep<(15 - I < AT_RING - 1 ? 15 - I : AT_RING - 1)>(ring[I % AT_RING]);
        oacc[I / 4] = __builtin_amdgcn_mfma_f32_32x32x16_bf16(ring[I % AT_RING], pf[I % 4], oacc[I / 4], 0, 0, 0);
        if constexpr (I + AT_RING < 16) ds_read128<((I + AT_RING) / 4) * 32 * AT_VP + ((I + AT_RING) % 4) * 32>(ring[I % AT_RING], vaddr);
        at_pv_steps<I + 1>(ring, vaddr, pf, oacc);
    }
}
__device__ __forceinline__ void attn_prompt_block(const Args& a, LAS unsigned char* lds, int b, int h, int qb) {
    int tid_ = threadIdx.x; asm volatile("" : "+v"(tid_));
    const int tid = tid_, lane = tid & 63, w = __builtin_amdgcn_readfirstlane(tid >> 6), qi = lane & 31, kh = lane >> 5;
    const bf16_t* Q = (const bf16_t*)(a.ws + WS_Q); const bf16_t* KN = (const bf16_t*)(a.ws + WS_KN); const bf16_t* KRB = (const bf16_t*)(a.ws + WS_KRB);
    const bf16_t* VT = (const bf16_t*)(a.ws + WS_VT); const bf16_t* C1 = (const bf16_t*)(a.ws + WS_C1); bf16_t* OG = (bf16_t*)(a.ws + WS_OG);
    const float* rc = (const float*)(a.ws + WS_ROPE); const float* rs = rc + 2052 * 32;
    const int q0 = qb * 256 + 32 * w, qpos = q0 + qi; const size_t mrow = (size_t)b * SEQ + qpos;
    const int half = w >> 2, htid = tid & 255;
    const bf16_t* gk = KN + ((size_t)(b * 8 + h) * SEQ + (htid >> 4)) * 128 + (htid & 15) * 8;
    const bf16_t* gr = KRB + ((size_t)b * SEQ + (htid >> 3)) * ROPE + (htid & 7) * 8;
    const bf16_t* gv = VT + ((size_t)(b * 8 + h) * 32 * 128 + (htid >> 3)) * 64 + (htid & 7) * 8;
    const int lk = (htid >> 4) * AT_KP + (htid & 15) * 16, lr_ = (htid >> 3) * AT_KP + 256 + (htid & 7) * 16, lv = AT_KB + (htid >> 3) * AT_VP + (htid & 7) * 16;
    u32x4 rk[4], rr[2], rv[4];
#define AT_LOAD(k0) do { _Pragma("unroll") for (int i_ = 0; i_ < 4; ++i_) rk[i_] = *(const u32x4*)(gk + ((size_t)(k0) + 16 * i_) * 128); \
        _Pragma("unroll") for (int i_ = 0; i_ < 2; ++i_) rr[i_] = *(const u32x4*)(gr + ((size_t)(k0) + 32 * i_) * ROPE); \
        _Pragma("unroll") for (int i_ = 0; i_ < 4; ++i_) rv[i_] = *(const u32x4*)(gv + (size_t)(k0) * 128 + (size_t)(32 * i_) * 64); } while (0)
#define AT_STORE(st) do { LAS unsigned char* sb_ = lds + (st) * AT_STAGE; \
        _Pragma("unroll") for (int i_ = 0; i_ < 4; ++i_) *(LAS u32x4*)(sb_ + lk + 16 * i_ * AT_KP) = rk[i_]; \
        _Pragma("unroll") for (int i_ = 0; i_ < 2; ++i_) *(LAS u32x4*)(sb_ + lr_ + 32 * i_ * AT_KP) = rr[i_]; \
        _Pragma("unroll") for (int i_ = 0; i_ < 4; ++i_) *(LAS u32x4*)(sb_ + lv + 32 * i_ * AT_VP) = rv[i_]; } while (0)
    AT_LOAD(half * 64);
    bf16x8 qf[12];
#pragma unroll
    for (int s = 0; s < 12; ++s) qf[s] = *(const bf16x8*)(Q + mrow * 1536 + h * 192 + 16 * s + 8 * kh);
#pragma unroll
    for (int pr = 0; pr < 2; ++pr) {
        const int jj0 = 16 * pr + 8 * kh;
        const u32x4 x1r = __builtin_bit_cast(u32x4, qf[8 + pr]), x2r = __builtin_bit_cast(u32x4, qf[10 + pr]);
        const f32x4 c0 = *(const f32x4*)(rc + qpos * 32 + jj0), c1 = *(const f32x4*)(rc + qpos * 32 + jj0 + 4), s0 = *(const f32x4*)(rs + qpos * 32 + jj0), s1 = *(const f32x4*)(rs + qpos * 32 + jj0 + 4);
        const float cc[8] = {c0.x, c0.y, c0.z, c0.w, c1.x, c1.y, c1.z, c1.w}, sn[8] = {s0.x, s0.y, s0.z, s0.w, s1.x, s1.y, s1.z, s1.w};
        const float x1[8] = {bflo(x1r.x), bfhi(x1r.x), bflo(x1r.y), bfhi(x1r.y), bflo(x1r.z), bfhi(x1r.z), bflo(x1r.w), bfhi(x1r.w)};
        const float x2[8] = {bflo(x2r.x), bfhi(x2r.x), bflo(x2r.y), bfhi(x2r.y), bflo(x2r.z), bfhi(x2r.z), bflo(x2r.w), bfhi(x2r.w)};
        float o1[8], o2[8];
#pragma unroll
        for (int e = 0; e < 8; ++e) { o1[e] = x1[e] * cc[e] - x2[e] * sn[e]; o2[e] = x1[e] * sn[e] + x2[e] * cc[e]; }
        u32x4 t; t.x = pk2(o1[0], o1[1]); t.y = pk2(o1[2], o1[3]); t.z = pk2(o1[4], o1[5]); t.w = pk2(o1[6], o1[7]); qf[8 + pr] = __builtin_bit_cast(bf16x8, t);
        t.x = pk2(o2[0], o2[1]); t.y = pk2(o2[2], o2[3]); t.z = pk2(o2[4], o2[5]); t.w = pk2(o2[6], o2[7]); qf[10 + pr] = __builtin_bit_cast(bf16x8, t);
    }
    f32x16 oacc[4];
#pragma unroll
    for (int d = 0; d < 4; ++d)
#pragma unroll
        for (int r = 0; r < 16; ++r) oacc[d][r] = 0.f;
    float m_run = -1e30f, lsum = 0.f;
    const int nt = 4 * (qb + 1);
    if (half == 0) { AT_STORE(0); }
    LDS_WAIT(); __syncthreads();
#pragma unroll
    for (int s = 0; s < 12; ++s) asm volatile("" :: "v"(qf[s]));
    if (half == 0) AT_LOAD(128);
    const int krow = pi32(qi) * AT_KP + kh * 16;
    const int vrow = AT_KB + qi * AT_VP + kh * 16;
    for (int jt = 0; jt < nt; ++jt) {
        const int k0 = jt * 64;
        const LAS unsigned char* sb = lds + (jt & 1) * AT_STAGE;
        const bool active = !(jt >= nt - 4 && 64 * (jt - (nt - 4)) > 32 * w + 31);
        if (active) {
        f32x16 sacc[2];
#pragma unroll
        for (int kb = 0; kb < 2; ++kb)
#pragma unroll
            for (int r = 0; r < 16; ++r) sacc[kb][r] = 0.f;
        bf16x8 ring[AT_RING];
        { const unsigned kaddr = (unsigned)(size_t)(sb + krow);
          ds_read128<0>(ring[0], kaddr); ds_read128<32>(ring[1], kaddr); ds_read128<64>(ring[2], kaddr); ds_read128<96>(ring[3], kaddr); ds_read128<128>(ring[4], kaddr); ds_read128<160>(ring[5], kaddr);
          at_qk_steps<0>(ring, kaddr, qf, sacc); }
        if (jt >= nt - 4) {
#pragma unroll
            for (int kb = 0; kb < 2; ++kb)
#pragma unroll
                for (int r = 0; r < 16; ++r) { const int key = k0 + 32 * kb + (r & 3) + 4 * ((r >> 2) & 1) + 8 * kh + 16 * (r >> 3); if (key > qpos) sacc[kb][r] = -INFINITY; }
        }
        float mx = sacc[0][0];
#pragma unroll
        for (int kb = 0; kb < 2; ++kb)
#pragma unroll
            for (int r = 0; r < 16; ++r) mx = fmaxf(mx, sacc[kb][r]);
        mx = fmaxf(mx, __shfl_xor(mx, 32));
        const float m_tile = mx * SM_SCALE_LOG2;
        if (__any(m_tile > m_run + 8.0f)) {
            const float m_new = fmaxf(m_run, m_tile);
            const float alpha = fast_exp2(m_run - m_new); m_run = m_new;
            lsum *= alpha;
#pragma unroll
            for (int d = 0; d < 4; ++d)
#pragma unroll
                for (int r = 0; r < 16; ++r) oacc[d][r] *= alpha;
        }
        float ps = 0.f;
#pragma unroll
        for (int kb = 0; kb < 2; ++kb)
#pragma unroll
            for (int r = 0; r < 16; ++r) { const float pv = fast_exp2(fmaf(sacc[kb][r], SM_SCALE_LOG2, -m_run)); sacc[kb][r] = pv; ps += pv; }
        lsum += ps;
        bf16x8 pf[4];
#pragma unroll
        for (int ks = 0; ks < 4; ++ks) { const int kb = ks >> 1, rb = 8 * (ks & 1); u32x4 t; t.x = pk2(sacc[kb][rb], sacc[kb][rb + 1]); t.y = pk2(sacc[kb][rb + 2], sacc[kb][rb + 3]); t.z = pk2(sacc[kb][rb + 4], sacc[kb][rb + 5]); t.w = pk2(sacc[kb][rb + 6], sacc[kb][rb + 7]); pf[ks] = __builtin_bit_cast(bf16x8, t); }
        { const unsigned vaddr = (unsigned)(size_t)(sb + vrow);
          ds_read128<0>(ring[0], vaddr); ds_read128<32>(ring[1], vaddr); ds_read128<64>(ring[2], vaddr); ds_read128<96>(ring[3], vaddr); ds_read128<32 * AT_VP>(ring[4], vaddr); ds_read128<32 * AT_VP + 32>(ring[5], vaddr);
          at_pv_steps<0>(ring, vaddr, pf, oacc); }
        }
        if (((jt + 1) & 1) == half && jt + 1 < nt) { AT_STORE((jt + 1) & 1); if (jt + 3 < nt) AT_LOAD(k0 + 192); }
        WG_BAR();
    }
#undef AT_LOAD
#undef AT_STORE
    const float ltot = lsum + __shfl_xor(lsum, 32); const float inv = 1.0f / ltot;
    u32x4 gall[8];
#pragma unroll
    for (int i = 0; i < 8; ++i) gall[i] = *(const u32x4*)(C1 + mrow * LDC1 + QL + h * 128 + 32 * (i >> 1) + 16 * (i & 1) + 8 * kh);
#pragma unroll
    for (int d = 0; d < 4; ++d)
#pragma unroll
        for (int p = 0; p < 2; ++p) {
            float lo[4], hi[4];
#pragma unroll
            for (int e = 0; e < 4; ++e) { const float qa = oacc[d][8 * p + e], qb_ = oacc[d][8 * p + 4 + e];
                const float recv = __shfl_xor(kh ? qa : qb_, 32);
                lo[e] = kh ? recv : qa; hi[e] = kh ? qb_ : recv; }
            const u32x4 gr = gall[d * 2 + p];
            u32x4 o;
            o.x = pk2(lo[0] * inv * siluf_(bflo(gr.x)), lo[1] * inv * siluf_(bfhi(gr.x))); o.y = pk2(lo[2] * inv * siluf_(bflo(gr.y)), lo[3] * inv * siluf_(bfhi(gr.y)));
            o.z = pk2(hi[0] * inv * siluf_(bflo(gr.z)), hi[1] * inv * siluf_(bfhi(gr.z))); o.w = pk2(hi[2] * inv * siluf_(bflo(gr.w)), hi[3] * inv * siluf_(bfhi(gr.w)));
            *(u32x4*)(OG + mrow * D + h * 128 + 32 * d + 16 * p + 8 * kh) = o;
        }
}

template <int OFF> __device__ __forceinline__ void ds_read_tr64(u32x2& d, unsigned addr) { asm volatile("ds_read_b64_tr_b16 %0, %1 offset:%2" : "=v"(d) : "v"(addr), "n"(OFF)); }
template <int N> __device__ __forceinline__ void lgkm_wait_dep3(bf16x8& x, bf16x8& y, bf16x8& z) { asm volatile("s_waitcnt lgkmcnt(%3)" : "+v"(x), "+v"(y), "+v"(z) : "n"(N)); }
template <int N> __device__ __forceinline__ void lgkm_wait_dep3t(bf16x8& x, u32x2& y, u32x2& z) { asm volatile("s_waitcnt lgkmcnt(%3)" : "+v"(x), "+v"(y), "+v"(z) : "n"(N)); }
constexpr int SA_KP = 656, SA_KN = 0, SA_QS = 128 * SA_KP  , SA_PP = 272, SA_PT = SA_QS + 32 * SA_KP  , SA_MX = SA_PT + 32 * SA_PP  , SA_PS = SA_MX + 1024  ;
template <int I> __device__ __forceinline__ void sa_qk_steps(bf16x8 (&kr)[3], bf16x8 (&qa)[3], bf16x8 (&qb)[3], unsigned kaddr, unsigned qaddr, f32x4& s0, f32x4& s1) {
    if constexpr (I < 10) {
        lgkm_wait_dep3<(9 - I < 2 ? 3 * (9 - I) : 6)>(kr[I % 3], qa[I % 3], qb[I % 3]);
        s0 = __builtin_amdgcn_mfma_f32_16x16x32_bf16(kr[I % 3], qa[I % 3], s0, 0, 0, 0);
        s1 = __builtin_amdgcn_mfma_f32_16x16x32_bf16(kr[I % 3], qb[I % 3], s1, 0, 0, 0);
        if constexpr (I + 3 < 10) { ds_read128<(I + 3) * 64>(kr[I % 3], kaddr); ds_read128<(I + 3) * 64>(qa[I % 3], qaddr); ds_read128<(I + 3) * 64 + 16 * SA_KP>(qb[I % 3], qaddr); }
        sa_qk_steps<I + 1>(kr, qa, qb, kaddr, qaddr, s0, s1);
    }
}
template <int I> __device__ __forceinline__ void sa_pv_steps(bf16x8 (&pf)[3], u32x2 (&ta)[3], u32x2 (&tb)[3], unsigned paddr, unsigned va0, unsigned va1, f32x16& oacc) {
    if constexpr (I < 8) {
        lgkm_wait_dep3t<(7 - I < 2 ? 3 * (7 - I) : 6)>(pf[I % 3], ta[I % 3], tb[I % 3]);
        u32x4 v; v.x = ta[I % 3].x; v.y = ta[I % 3].y; v.z = tb[I % 3].x; v.w = tb[I % 3].y;
        oacc = __builtin_amdgcn_mfma_f32_32x32x16_bf16(__builtin_bit_cast(bf16x8, v), pf[I % 3], oacc, 0, 0, 0);
        if constexpr (I + 3 < 8) { ds_read128<(I + 3) * 32>(pf[I % 3], paddr);
            ds_read_tr64<((I + 3) & 3) * 16 * SA_KP>(ta[I % 3], (I + 3) < 4 ? va0 : va1); ds_read_tr64<((I + 3) & 3) * 16 * SA_KP + 4 * SA_KP>(tb[I % 3], (I + 3) < 4 ? va0 : va1); }
        sa_pv_steps<I + 1>(pf, ta, tb, paddr, va0, va1, oacc);
    }
}
__device__ __forceinline__ void attn_sample_unit(const Args& a, LAS unsigned char* lds, int s, int sp) {
    int tid_ = threadIdx.x; asm volatile("" : "+v"(tid_));
    const int tid = tid_, lane = tid & 63, w = __builtin_amdgcn_readfirstlane(tid >> 6), qi = lane & 31, kh = lane >> 5;
    const bf16_t* Q = (const bf16_t*)(a.ws + WS_Q); const bf16_t* WUKB = (const bf16_t*)(a.ws + WS_WUKB); const bf16_t* LATB = (const bf16_t*)(a.ws + WS_LATB); const bf16_t* KRB = (const bf16_t*)(a.ws + WS_KRB);
    const float* rc = (const float*)(a.ws + WS_ROPE); const float* rs = rc + 2052 * 32;
    float* PART = (float*)(a.ws + WS_PART) + (size_t)(s * 2 + sp) * PART_STRIDE;
    const size_t row0 = (size_t)MP + (size_t)s * 4;
    f32x4 rl[16], rr[4];
    const int ptv = a.page_table[s * NPAGES + sp * 32 + (lane & 31)];
#define SA_LOAD(jt) do { const int phys_ = __builtin_amdgcn_readlane(ptv, (jt)); const size_t kb_ = (size_t)phys_ * PAGE; \
        _Pragma("unroll") for (int i_ = 0; i_ < 4; ++i_) rr[i_] = __builtin_nontemporal_load((const f32x4*)(a.cache_krope + kb_ * ROPE) + tid + 512 * i_); \
        _Pragma("unroll") for (int i_ = 0; i_ < 16; ++i_) rl[i_] = __builtin_nontemporal_load((const f32x4*)(a.cache_latent + kb_ * KVL) + tid + 512 * i_); } while (0)
    SA_LOAD(0);
    {
        const int h = w;
        bf16x8 bq[8];
#pragma unroll
        for (int st = 0; st < 8; ++st) bq[st] = *(const bf16x8*)(Q + (row0 + (qi & 3)) * 1536 + h * 192 + 16 * st + 8 * kh);
#pragma unroll
        for (int st = 0; st < 8; ++st) { if (qi >= 4) bq[st] = (bf16x8){0, 0, 0, 0, 0, 0, 0, 0}; }
        bf16x8 afn[8];
#pragma unroll
        for (int st = 0; st < 8; ++st) afn[st] = *(const bf16x8*)(WUKB + (size_t)qi * 1024 + h * 128 + 16 * st + 8 * kh);
        for (int cb = 0; cb < 8; ++cb) {
            f32x16 acc;
#pragma unroll
            for (int r = 0; r < 16; ++r) acc[r] = 0.f;
            bf16x8 af[8];
#pragma unroll
            for (int st = 0; st < 8; ++st) af[st] = afn[st];
            if (cb + 1 < 8) {
#pragma unroll
                for (int st = 0; st < 8; ++st) afn[st] = *(const bf16x8*)(WUKB + (size_t)(32 * (cb + 1) + qi) * 1024 + h * 128 + 16 * st + 8 * kh);
            }
#pragma unroll
            for (int st = 0; st < 8; ++st) acc = __builtin_amdgcn_mfma_f32_32x32x16_bf16(af[st], bq[st], acc, 0, 0, 0);
            if (qi < 4) {
#pragma unroll
                for (int rq = 0; rq < 4; ++rq) { const int c0 = 32 * cb + 8 * rq + 4 * kh; u32x2 o; o.x = pk2(acc[4 * rq] * SM_SCALE_LOG2, acc[4 * rq + 1] * SM_SCALE_LOG2); o.y = pk2(acc[4 * rq + 2] * SM_SCALE_LOG2, acc[4 * rq + 3] * SM_SCALE_LOG2);
                    *(LAS u32x2*)(lds + SA_QS + (qi * 8 + h) * SA_KP + c0 * 2) = o; }
            }
        }
        { const int t = lane >> 4, j0 = 2 * (lane & 15); const bf16_t* qr = Q + (row0 + t) * 1536 + h * 192 + 128;
          const unsigned x1r = *(const unsigned*)(qr + j0), x2r = *(const unsigned*)(qr + 32 + j0);
          const int idx = 2048 + t; const float c0 = rc[idx * 32 + j0], c1 = rc[idx * 32 + j0 + 1], s0 = rs[idx * 32 + j0], s1 = rs[idx * 32 + j0 + 1];
          const float a0 = bflo(x1r), a1 = bfhi(x1r), b0 = bflo(x2r), b1 = bfhi(x2r);
          *(LAS unsigned*)(lds + SA_QS + (t * 8 + h) * SA_KP + (256 + j0) * 2) = pk2((a0 * c0 - b0 * s0) * SM_SCALE_LOG2, (a1 * c1 - b1 * s1) * SM_SCALE_LOG2);
          *(LAS unsigned*)(lds + SA_QS + (t * 8 + h) * SA_KP + (256 + 32 + j0) * 2) = pk2((a0 * s0 + b0 * c0) * SM_SCALE_LOG2, (a1 * s1 + b1 * c1) * SM_SCALE_LOG2); }
    }
    LDS_WAIT(); __syncthreads();
#define SA_BAR() WG_BAR()
    f32x16 oacc;
#pragma unroll
    for (int r = 0; r < 16; ++r) oacc[r] = 0.f;
    float m_run = -1e30f, lsum = 0.f, m_own0 = -1e30f, m_own1 = -1e30f;
#define SA_STORE() do { \
        _Pragma("unroll") for (int i_ = 0; i_ < 16; ++i_) { const int c_ = tid + 512 * i_; u32x2 t_; t_.x = pk2(rl[i_].x, rl[i_].y); t_.y = pk2(rl[i_].z, rl[i_].w); \
            *(LAS u32x2*)(lds + SA_KN + (c_ >> 6) * SA_KP + 8 * (c_ & 63)) = t_; } \
        _Pragma("unroll") for (int i_ = 0; i_ < 4; ++i_) { const int c_ = tid + 512 * i_; u32x2 t_; t_.x = pk2(rr[i_].x, rr[i_].y); t_.y = pk2(rr[i_].z, rr[i_].w); \
            *(LAS u32x2*)(lds + SA_KN + (c_ >> 4) * SA_KP + 512 + 8 * (c_ & 15)) = t_; } } while (0)
    const int c16 = lane & 15, q4 = lane >> 4;
    const unsigned kaddr = (unsigned)(size_t)(lds + SA_KN + (16 * w + c16) * SA_KP + q4 * 16);
    const unsigned qaddr = (unsigned)(size_t)(lds + SA_QS + c16 * SA_KP + q4 * 16);
    LAS float* MXw = (LAS float*)(lds + SA_MX) + w * 32 + c16;
    LAS float* PSw = (LAS float*)(lds + SA_PS) + w * 32 + c16;
    const LAS float* MXo = (const LAS float*)(lds + SA_MX) + c16;
    const LAS float* PSn = (const LAS float*)(lds + SA_PS) + qi;
    LAS unsigned char* ptw = lds + SA_PT + c16 * SA_PP + (16 * w + 4 * q4) * 2;
    const unsigned paddr = (unsigned)(size_t)(lds + SA_PT + qi * SA_PP + kh * 16);
    const unsigned va0 = (unsigned)(size_t)(lds + SA_KN + (8 * (q4 >> 1) + (c16 >> 2)) * SA_KP + (32 * w + 16 * (q4 & 1) + 4 * (c16 & 3)) * 2);
    const unsigned va1 = va0 + 64 * SA_KP;
#define SA_COMPUTE(special) do { \
        f32x4 s0_ = {0.f, 0.f, 0.f, 0.f}, s1_ = {0.f, 0.f, 0.f, 0.f}; \
        { bf16x8 kr_[3], qa_[3], qb_[3]; \
          ds_read128<0>(kr_[0], kaddr); ds_read128<0>(qa_[0], qaddr); ds_read128<16 * SA_KP>(qb_[0], qaddr); \
          ds_read128<64>(kr_[1], kaddr); ds_read128<64>(qa_[1], qaddr); ds_read128<64 + 16 * SA_KP>(qb_[1], qaddr); \
          ds_read128<128>(kr_[2], kaddr); ds_read128<128>(qa_[2], qaddr); ds_read128<128 + 16 * SA_KP>(qb_[2], qaddr); \
          sa_qk_steps<0>(kr_, qa_, qb_, kaddr, qaddr, s0_, s1_); } \
        if (special) { const int t0_ = c16 >> 3, t1_ = (16 + c16) >> 3; \
            _Pragma("unroll") for (int r_ = 0; r_ < 4; ++r_) { if (16 * w + 4 * q4 + r_ > t0_) s0_[r_] = -INFINITY; if (16 * w + 4 * q4 + r_ > t1_) s1_[r_] = -INFINITY; } } \
        { float mx0_ = fmaxf(fmaxf(s0_[0], s0_[1]), fmaxf(s0_[2], s0_[3])), mx1_ = fmaxf(fmaxf(s1_[0], s1_[1]), fmaxf(s1_[2], s1_[3])); \
          mx0_ = fmaxf(mx0_, __shfl_xor(mx0_, 16)); mx1_ = fmaxf(mx1_, __shfl_xor(mx1_, 16)); mx0_ = fmaxf(mx0_, __shfl_xor(mx0_, 32)); mx1_ = fmaxf(mx1_, __shfl_xor(mx1_, 32)); \
          if (q4 == 0) { MXw[0] = mx0_; MXw[16] = mx1_; } } \
        SA_BAR(); \
        { float mt0_ = MXo[0], mt1_ = MXo[16]; \
          _Pragma("unroll") for (int w_ = 1; w_ < 8; ++w_) { mt0_ = fmaxf(mt0_, MXo[32 * w_]); mt1_ = fmaxf(mt1_, MXo[32 * w_ + 16]); } \
          m_own0 = fmaxf(m_own0, mt0_); m_own1 = fmaxf(m_own1, mt1_); \
          const float a0_ = fast_exp2(s0_[0] - m_own0), a1_ = fast_exp2(s0_[1] - m_own0), a2_ = fast_exp2(s0_[2] - m_own0), a3_ = fast_exp2(s0_[3] - m_own0); \
          const float b0_ = fast_exp2(s1_[0] - m_own1), b1_ = fast_exp2(s1_[1] - m_own1), b2_ = fast_exp2(s1_[2] - m_own1), b3_ = fast_exp2(s1_[3] - m_own1); \
          float ps0_ = (a0_ + a1_) + (a2_ + a3_), ps1_ = (b0_ + b1_) + (b2_ + b3_); \
          ps0_ += __shfl_xor(ps0_, 16); ps1_ += __shfl_xor(ps1_, 16); ps0_ += __shfl_xor(ps0_, 32); ps1_ += __shfl_xor(ps1_, 32); \
          if (q4 == 0) { PSw[0] = ps0_; PSw[16] = ps1_; } \
          u32x2 pw_; pw_.x = pk2(a0_, a1_); pw_.y = pk2(a2_, a3_); *(LAS u32x2*)ptw = pw_; pw_.x = pk2(b0_, b1_); pw_.y = pk2(b2_, b3_); *(LAS u32x2*)(ptw + 16 * SA_PP) = pw_; } \
        SA_BAR(); \
        { const float m_new_ = (lane & 16) ? m_own1 : m_own0; const float alpha_ = fast_exp2(m_run - m_new_); m_run = m_new_; \
          float sum_ = PSn[0]; \
          _Pragma("unroll") for (int w_ = 1; w_ < 8; ++w_) sum_ += PSn[32 * w_]; \
          lsum = lsum * alpha_ + sum_; \
          _Pragma("unroll") for (int r_ = 0; r_ < 16; ++r_) oacc[r_] *= alpha_; \
          bf16x8 pf_[3]; u32x2 ta_[3], tb_[3]; \
          ds_read128<0>(pf_[0], paddr); ds_read_tr64<0>(ta_[0], va0); ds_read_tr64<4 * SA_KP>(tb_[0], va0); \
          ds_read128<32>(pf_[1], paddr); ds_read_tr64<16 * SA_KP>(ta_[1], va0); ds_read_tr64<20 * SA_KP>(tb_[1], va0); \
          ds_read128<64>(pf_[2], paddr); ds_read_tr64<32 * SA_KP>(ta_[2], va0); ds_read_tr64<36 * SA_KP>(tb_[2], va0); \
          sa_pv_steps<0>(pf_, ta_, tb_, paddr, va0, va1, oacc); } \
    } while (0)
    for (int jt = 0; jt < 32; ++jt) {
        SA_STORE();
        if (jt + 1 < 32) SA_LOAD(jt + 1);
        SA_BAR();
        SA_COMPUTE(false); SA_BAR();
    }
    if (sp == 1) {
        for (int i = tid; i < 16 * SA_KP / 16; i += 512) *(LAS u32x4*)(lds + SA_KN + i * 16) = (u32x4){0u, 0u, 0u, 0u};
        SA_BAR();
        if (tid < 4 * 40) { const int t = tid / 40, ch = tid % 40;
            const u32x4 v = ch < 32 ? *(const u32x4*)(LATB + (row0 + t) * KVL + 8 * ch) : *(const u32x4*)(KRB + (row0 + t) * ROPE + 8 * (ch - 32));
            *(LAS u32x4*)(lds + SA_KN + t * SA_KP + 16 * ch) = v; }
        SA_BAR();
        SA_COMPUTE(true); SA_BAR();
    }
#undef SA_LOAD
#undef SA_STORE
#undef SA_COMPUTE
#undef SA_BAR
    if (w == 0 && kh == 0) { PART[qi] = m_run; PART[32 + qi] = lsum; }
#pragma unroll
    for (int q = 0; q < 4; ++q) { f32x4 v; v.x = oacc[4 * q]; v.y = oacc[4 * q + 1]; v.z = oacc[4 * q + 2]; v.w = oacc[4 * q + 3];
        *(f32x4*)(PART + 64 + qi * 256 + 32 * w + 8 * q + 4 * kh) = v; }
    VM_WAIT(); __syncthreads();
}
constexpr int CB_P = 528;
__device__ __forceinline__ void sample_combine(const Args& a, LAS unsigned char* lds, int s, int hh) {
    int tid_ = threadIdx.x; asm volatile("" : "+v"(tid_)); const int tid = tid_, lane = tid & 63, w = __builtin_amdgcn_readfirstlane(tid >> 6), qi = lane & 31, kh = lane >> 5;
    const float* P0 = (const float*)(a.ws + WS_PART) + (size_t)(s * 2) * PART_STRIDE; const float* P1 = P0 + PART_STRIDE;
    const bf16_t* C1 = (const bf16_t*)(a.ws + WS_C1); bf16_t* OG = (bf16_t*)(a.ws + WS_OG); const bf16_t* WUV = (const bf16_t*)(a.ws + WS_WUV);
    const int h = 4 * hh + (w & 3), vb0 = 2 * (w >> 2);
    bf16x8 afn[16];
#pragma unroll
    for (int st = 0; st < 16; ++st) afn[st] = *(const bf16x8*)(WUV + (size_t)(h * 128 + 32 * vb0 + qi) * 256 + 16 * st + 8 * kh);
#pragma unroll
    for (int k = 0; k < 2; ++k) { const int i = tid + 512 * k, ri = i >> 6, dq = i & 63, n = (ri >> 2) * 8 + 4 * hh + (ri & 3);
        const f32x4 a0 = *(const f32x4*)(P0 + 64 + n * 256 + 4 * dq), a1 = *(const f32x4*)(P1 + 64 + n * 256 + 4 * dq);
        const float m0 = P0[n], m1 = P1[n], l0 = P0[32 + n], l1 = P1[32 + n]; const float mm = fmaxf(m0, m1), w0 = fast_exp2(m0 - mm), w1 = fast_exp2(m1 - mm); const float inv = 1.0f / (l0 * w0 + l1 * w1);
        u32x2 o; o.x = pk2((a0.x * w0 + a1.x * w1) * inv, (a0.y * w0 + a1.y * w1) * inv); o.y = pk2((a0.z * w0 + a1.z * w1) * inv, (a0.w * w0 + a1.w * w1) * inv);
        *(LAS u32x2*)(lds + n * CB_P + 8 * dq) = o; }
    LDS_WAIT(); __syncthreads();
    const size_t row0 = (size_t)MP + (size_t)s * 4;
    bf16x8 bq[16];
#pragma unroll
    for (int st = 0; st < 16; ++st) { bf16x8 z = {0, 0, 0, 0, 0, 0, 0, 0}; if (qi < 4) z = *(const LAS bf16x8*)(lds + (qi * 8 + h) * CB_P + (16 * st + 8 * kh) * 2); bq[st] = z; }
    for (int vb = vb0; vb < vb0 + 2; ++vb) {
        f32x16 acc;
#pragma unroll
        for (int r = 0; r < 16; ++r) acc[r] = 0.f;
        bf16x8 af[16];
#pragma unroll
        for (int st = 0; st < 16; ++st) af[st] = afn[st];
        if (vb + 1 < vb0 + 2) {
#pragma unroll
            for (int st = 0; st < 16; ++st) afn[st] = *(const bf16x8*)(WUV + (size_t)(h * 128 + 32 * (vb + 1) + qi) * 256 + 16 * st + 8 * kh);
        }
#pragma unroll
        for (int st = 0; st < 16; ++st) acc = __builtin_amdgcn_mfma_f32_32x32x16_bf16(af[st], bq[st], acc, 0, 0, 0);
        u32x2 gg[4];
#pragma unroll
        for (int rq = 0; rq < 4; ++rq) gg[rq] = *(const u32x2*)(C1 + (row0 + (qi & 3)) * LDC1 + QL + h * 128 + 32 * vb + 8 * rq + 4 * kh);
        if (qi < 4) {
#pragma unroll
            for (int rq = 0; rq < 4; ++rq) { const int v0 = h * 128 + 32 * vb + 8 * rq + 4 * kh;
                const u32x2 gr = gg[rq];
                u32x2 o; o.x = pk2(acc[4 * rq] * siluf_(bflo(gr.x)), acc[4 * rq + 1] * siluf_(bfhi(gr.x))); o.y = pk2(acc[4 * rq + 2] * siluf_(bflo(gr.y)), acc[4 * rq + 3] * siluf_(bfhi(gr.y)));
                *(u32x2*)(OG + (row0 + qi) * D + v0) = o; }
        }
    }
    __syncthreads();
}

constexpr int NPHASE = 21;
__global__ void __launch_bounds__(512, 2) yoco_fwd(Args a) {
    extern __shared__ __attribute__((aligned(16))) unsigned char lds_raw[];
    LAS unsigned char* lds = (LAS unsigned char*)lds_raw;
    const int tid = threadIdx.x;
    const int G = gridDim.x, wg = blockIdx.x;
    const int ngw = G * 8, gthreads = G * 512;
#define OPQ_TID() int tq_ = threadIdx.x; asm volatile("" : "+v"(tq_)); const int lane = tq_ & 63, wave = __builtin_amdgcn_readfirstlane(tq_ >> 6), gw = wg * 8 + wave, gtid = wg * 512 + tq_; (void)lane; (void)gw; (void)gtid; (void)wave
    volatile LAS unsigned* ctlw = (volatile LAS unsigned*)(lds + LDS_CTL_OFF);
    if (tid < 4) ctlw[tid] = 0u;
    __syncthreads();
    unsigned* barw = (unsigned*)(a.ws + WS_CTL) + 1024;
    XcdBarrier bar; bar.bar = barw; bar.x = 0; bar.st = ctlw;
    const int lo = a.ph_lo, hi = a.ph_hi;
    const bool multi = (hi - lo) > 1;
    if (multi) bar = xcd_barrier_post(barw, ctlw);
    int ph = 0;
#define IN(k) (lo <= (k) && (k) < hi)
#define SEAM(k) do { if (IN(k) && IN((k) + 1)) xcd_barrier(bar); } while (0)
    unsigned char* ws = a.ws;
#define XB ((bf16_t*)(ws + WS_XB))
#define X ((float*)(ws + WS_X))
#define SSQ ((float*)(ws + WS_SSQ))
#define UZ ((bf16_t*)(ws + WS_UZ))
#define YG ((bf16_t*)(ws + WS_YG))
#define VB ((bf16_t*)(ws + WS_VB))
#define C1 ((bf16_t*)(ws + WS_C1))
#define CQN ((bf16_t*)(ws + WS_CQN))
#define LATB ((bf16_t*)(ws + WS_LATB))
#define QB ((bf16_t*)(ws + WS_Q))
#define KN ((bf16_t*)(ws + WS_KN))
#define VT ((bf16_t*)(ws + WS_VT))
#define OG ((bf16_t*)(ws + WS_OG))

    if (IN(ph)) {
        _Pragma("nounroll") for (int rep = 0; rep < REP_PRO; ++rep) { OPQ_TID(); prologue_phase(a, lds, gw, ngw, wave, lane, gtid, gthreads); }
    }
    SEAM(ph); ++ph;
    for (int i = 0; i < 2; ++i) {
        if (IN(ph)) {
            _Pragma("nounroll") for (int rep = 0; rep < REP_G1; ++rep) {
            { pg8::Gemm g{XB, (const bf16_t*)(ws + WS_WIN) + (size_t)i * 4096 * 1024, MP, 4096, 1024}; pg8::StaticOrder S; { int wgq_ = blockIdx.x; asm volatile("" : "+s"(wgq_)); S.init(MP, 4096, G, wgq_); }
              pg8::EpiScale<true> E{UZ, 4096, SSQ, 1.0f / D}; pg8::gemm_phase<pg8::EpiScale<true>, pg8::StaticOrder, true, true>(lds, g, S, E); }
            { sk::SkScale<true> E{UZ, 4096, SSQ, 1.0f / D}; for (int rs_ = 0; rs_ < REP_SK; ++rs_) sk::gemm(lds, XB + (size_t)MP * 1024, (const bf16_t*)(ws + WS_WIN) + (size_t)i * 4096 * 1024, 1024, 64, E, wg, G); } }
        }
        SEAM(ph); ++ph;
        if (IN(ph)) { _Pragma("nounroll") for (int rep = 0; rep < REP_SCAN; ++rep) scan_phase(a, i, lds, wg, G); }
        SEAM(ph); ++ph;
        if (IN(ph)) {
            _Pragma("nounroll") for (int rep = 0; rep < REP_G2; ++rep) {
            { pg8::Gemm g{YG, (const bf16_t*)(ws + WS_WGLU) + (size_t)i * 4096 * 2048, MP, 4096, 2048}; pg8::StaticOrder S; { int wgq_ = blockIdx.x; asm volatile("" : "+s"(wgq_)); S.init(MP, 4096, G, wgq_); }
              pg8::EpiGlu E{VB, UZ, a.b_glu + (size_t)i * 4096}; pg8::gemm_phase<pg8::EpiGlu, pg8::StaticOrder, true, true>(lds, g, S, E); }
            { sk::SkGlu E{VB, UZ, a.b_glu + (size_t)i * 4096}; for (int rs_ = 0; rs_ < REP_SK; ++rs_) sk::gemm(lds, YG + (size_t)MP * 2048, (const bf16_t*)(ws + WS_WGLU) + (size_t)i * 4096 * 2048, 2048, 64, E, wg, G); } }
        }
        SEAM(ph); ++ph;
        if (IN(ph)) { { pg8::Gemm g{VB, (const bf16_t*)(ws + WS_WOUT) + (size_t)i * 1024 * 2048, MP, 1024, 2048}; pg8::StaticOrder S; { int wgq_ = blockIdx.x; asm volatile("" : "+s"(wgq_)); S.init(MP, 1024, G, wgq_); }
            pg8::EpiRes E{X, XB, SSQ, i == 0 ? a.x_prompt : nullptr, a.x_sample}; pg8::gemm_phase<pg8::EpiRes, pg8::StaticOrder, true, true>(lds, g, S, E); }
            { sk::SkRes E{X, XB, SSQ, i == 0 ? a.x_sample : nullptr}; sk::gemm(lds, VB + (size_t)MP * 2048, (const bf16_t*)(ws + WS_WOUT) + (size_t)i * 1024 * 2048, 2048, 16, E, wg, G); } }
        SEAM(ph); ++ph;
    }
    for (int j = 0; j < 2; ++j) {
        if (IN(ph)) {
            _Pragma("nounroll") for (int rep = 0; rep < REP_M1; ++rep) {
            const int N1 = j == 0 ? N1A : N1B;
            { pg8::Gemm g{XB, (const bf16_t*)(ws + WS_WINB) + (size_t)j * 1792 * 1024, MP, N1, 1024}; pg8::StaticOrder S; { int wgq_ = blockIdx.x; asm volatile("" : "+s"(wgq_)); S.init(MP, N1, G, wgq_); }
              pg8::EpiScale<true, 0, true> E{C1, LDC1, SSQ, 1.0f / D, (float*)(ws + WS_SSQ2)}; pg8::gemm_phase<pg8::EpiScale<true, 0, true>, pg8::StaticOrder, true, true>(lds, g, S, E); }
            { sk::SkScale<true, true> E{C1, LDC1, SSQ, 1.0f / D, (float*)(ws + WS_SSQ2)}; for (int rs_ = 0; rs_ < REP_SK; ++rs_) sk::gemm(lds, XB + (size_t)MP * 1024, (const bf16_t*)(ws + WS_WINB) + (size_t)j * 1792 * 1024, 1024, N1 / 64, E, wg, G); } }
        }
        SEAM(ph); ++ph;
        if (j == 0) {
        if (IN(ph)) { _Pragma("nounroll") for (int rep = 0; rep < REP_THIN; ++rep) { OPQ_TID(); t1_phase(a, j, gw, ngw, lane); } }
        SEAM(ph); ++ph;
        }
        if (IN(ph)) {
            _Pragma("nounroll") for (int rep = 0; rep < REP_M2; ++rep) {
            { pg8::Gemm g{C1, (const bf16_t*)(ws + WS_WUQ) + (size_t)j * 1536 * 384, MP, 1536, 384, LDC1}; pg8::StaticOrder S; { int wgq_ = blockIdx.x; asm volatile("" : "+s"(wgq_)); S.init(MP, 1536, G, wgq_); }
              pg8::EpiScale<true> E{QB, 1536, (const float*)(ws + WS_SSQ2), 1.0f / QL}; pg8::gemm_phase<pg8::EpiScale<true>, pg8::StaticOrder, true, true>(lds, g, S, E); }
            { sk::SkScale<true> E{QB, 1536, (const float*)(ws + WS_SSQ2), 1.0f / QL}; for (int rs_ = 0; rs_ < REP_SK; ++rs_) sk::gemm(lds, C1 + (size_t)MP * LDC1, (const bf16_t*)(ws + WS_WUQ) + (size_t)j * 1536 * 384, 384, 24, E, wg, G, LDC1); }
            if (j == 0) {
                { pg8::Gemm g{LATB, (const bf16_t*)(ws + WS_WUK), MP, 1024, 256}; pg8::StaticOrder S; { int wgq_ = blockIdx.x; asm volatile("" : "+s"(wgq_)); S.init(MP, 1024, G, wgq_); }
                  pg8::EpiScale<false, 1> E{KN, 1024, nullptr, 0.f}; pg8::gemm_phase<pg8::EpiScale<false, 1>, pg8::StaticOrder, true, true>(lds, g, S, E); }
                { pg8::Gemm g{(const bf16_t*)(ws + WS_WUV), LATB, 1024, MP, 256}; pg8::StaticOrder S; { int wgq_ = blockIdx.x; asm volatile("" : "+s"(wgq_)); S.init(1024, MP, G, wgq_); }
                  pg8::EpiScale<false, 2> E{VT, MP, nullptr, 0.f}; pg8::gemm_phase<pg8::EpiScale<false, 2>, pg8::StaticOrder, true, true>(lds, g, S, E); }
            } }
        }
        SEAM(ph); ++ph;
        if (IN(ph)) {
            _Pragma("nounroll") for (int rep = 0; rep < REP_ATTP; ++rep)
            for (int it = ((wg & 7) * (G >> 3) + (wg >> 3)); it < 512; it += G) { const int x = it & 3, h = (it >> 2) & 7, b = it >> 5;
                attn_prompt_block(a, lds, b, h, 7 - x); attn_prompt_block(a, lds, b, h, x); }
            _Pragma("nounroll") for (int rep = 0; rep < REP_ATTS; ++rep)
            for (int it = wg; it < 256; it += G) attn_sample_unit(a, lds, it >> 1, it & 1);
        }
        SEAM(ph); ++ph;
        if (IN(ph)) { _Pragma("nounroll") for (int rep = 0; rep < REP_THIN; ++rep) for (int it = wg; it < 256; it += G) sample_combine(a, lds, it >> 1, it & 1); }
        SEAM(ph); ++ph;
        if (IN(ph)) { { pg8::Gemm g{OG, (const bf16_t*)(ws + WS_WOUTB) + (size_t)j * 1024 * 1024, MP, 1024, 1024}; pg8::StaticOrder S; { int wgq_ = blockIdx.x; asm volatile("" : "+s"(wgq_)); S.init(MP, 1024, G, wgq_); }
            pg8::EpiRes E{X, XB, SSQ, nullptr, nullptr}; pg8::gemm_phase<pg8::EpiRes, pg8::StaticOrder, true, true>(lds, g, S, E); }
            { sk::SkRes E{X, XB, SSQ, nullptr}; sk::gemm(lds, OG + (size_t)MP * 1024, (const bf16_t*)(ws + WS_WOUTB) + (size_t)j * 1024 * 1024, 1024, 16, E, wg, G); } }
        SEAM(ph); ++ph;
    }
    if (IN(ph)) { _Pragma("nounroll") for (int rep = 0; rep < REP_THIN; ++rep) { OPQ_TID(); final_phase(a, gw, ngw, lane); } }
#undef IN
#undef SEAM
#undef XB
#undef X
#undef SSQ
#undef UZ
#undef YG
#undef VB
#undef C1
#undef CQN
#undef LATB
#undef QB
#undef KN
#undef VT
#undef OG
}

extern "C" void kernel_launch(void* const* d_in, const int* in_sizes, int n_in, void* d_out, int out_size, void* d_ws, size_t ws_size, hipStream_t stream) {
    static int grid = 0;
    if (grid == 0) {
        if (n_in != 31 || ws_size < WS_END) { fprintf(stderr, "kernel_launch: unexpected inputs (n_in %d, ws %zu)\n", n_in, ws_size); grid = -1; return; }
        int dev = 0, cus = 0, per_cu = 0;
        if (hipGetDevice(&dev) != hipSuccess || hipDeviceGetAttribute(&cus, hipDeviceAttributeMultiprocessorCount, dev) != hipSuccess) { grid = -1; return; }
        if (hipFuncSetAttribute((const void*)yoco_fwd, hipFuncAttributeMaxDynamicSharedMemorySize, LDS_BYTES) != hipSuccess) { fprintf(stderr, "kernel_launch: hipFuncSetAttribute failed\n"); grid = -1; return; }
        if (hipOccupancyMaxActiveBlocksPerMultiprocessor(&per_cu, (const void*)yoco_fwd, 512, LDS_BYTES) != hipSuccess || per_cu < 1) { fprintf(stderr, "kernel_launch: occupancy query says %d\n", per_cu); }
        (void)hipGetLastError();
        grid = cus;
    }
    if (grid < 0) return;
    (void)hipMemsetAsync((char*)d_ws + WS_CTL, 0, CTL_BYTES, stream);
    Args a{};
    const float* const* f = (const float* const*)d_in;
    a.x_prompt = f[0]; a.x_sample = f[1]; a.cache_latent = f[2]; a.cache_krope = f[3]; a.page_table = (const int*)d_in[4]; a.state_re = f[5]; a.state_im = f[6];
    a.norm_a = f[7]; a.w_in_a = f[8]; a.a_re = f[9]; a.a_im = f[10]; a.log_dt = f[11]; a.b_re = f[12]; a.b_im = f[13]; a.c_re = f[14]; a.c_im = f[15]; a.d_skip = f[16];
    a.w_glu = f[17]; a.b_glu = f[18]; a.w_out_a = f[19]; a.norm_kv = f[20]; a.w_dkv = f[21]; a.norm_latent = f[22]; a.w_uk = f[23]; a.w_uv = f[24];
    a.norm_b = f[25]; a.w_in_b = f[26]; a.norm_q = f[27]; a.w_uq = f[28]; a.w_out_b = f[29]; a.norm_f = f[30];
    a.out = (float*)d_out; a.ws = (unsigned char*)d_ws;
#if MK_ONE_LAUNCH
    a.ph_lo = 0; a.ph_hi = NPHASE;
    hipLaunchKernelGGL(yoco_fwd, dim3(grid), dim3(512), LDS_BYTES, stream, a);
#else
    for (int p = 0; p < NPHASE; ++p) { a.ph_lo = p; a.ph_hi = p + 1; hipLaunchKernelGGL(yoco_fwd, dim3(grid), dim3(512), LDS_BYTES, stream, a); }
#endif
}
```
